# Optimizing an MI355X kernel written in HIP

```python
import math
import jax, jax.numpy as jnp
from jax import lax
import numpy as np

D_MODEL = 1024
BATCH = 8
SEQ = 2048
DEPTH = 4

CHUNK = 64
N_META = 16
Q_BLOCK = 128
N_MIXERS = 3
NEG_INF = -1e30

REL_BUCKETS = 32
REL_MAX_DIST = 128
REL_HEADS = 16

D_FF = 2816

A_HEADS = 8
A_HD = 64
A_VD = 2 * A_HD

B_HEADS = 16
B_Q_RANK = 256
B_KV_RANK = 256
B_VD = 64
IDX_HEADS = 8
IDX_DIM = 64
TOPK_MAX = 256

C_Q_HEADS = 16
C_KV_HEADS = 2
C_GROUP = C_Q_HEADS // C_KV_HEADS
C_HD = 64
WINDOW = 128
WINDOW_CHUNKS = -(-WINDOW // CHUNK)
C_BEHIND = WINDOW_CHUNKS * CHUNK

kernel_name = "chunked_hybrid_diff_dsa_swa_macaron"


def _rms_norm(x, g=None, eps=1e-6):
    xf = x.astype(jnp.float32)
    y = xf * lax.rsqrt(jnp.mean(xf * xf, axis=-1, keepdims=True) + eps)
    if g is not None:
        y = y * g.astype(jnp.float32)
    return y.astype(x.dtype)


def _swiglu(x, wi, wo):
    a, b = jnp.split(x @ wi, 2, axis=-1)
    return (jax.nn.silu(a) * b) @ wo


def _chunk_id(p):
    return jnp.where(p < N_META, 0, 1 + (p - N_META) // CHUNK)


def _rel_bucket(rel):
    half = REL_BUCKETS // 2
    max_exact = half // 2
    n = jnp.abs(rel)
    large = max_exact + (jnp.log(jnp.maximum(n, 1).astype(jnp.float32) / max_exact)
                         / math.log(REL_MAX_DIST / max_exact) * (half - max_exact)).astype(jnp.int32)
    large = jnp.minimum(large, half - 1)
    return jnp.where(rel > 0, half, 0) + jnp.where(n < max_exact, n, large)


def _rel_bias(rel_bias, rel):
    return rel_bias[_rel_bucket(rel)]


def _to_blocks(a):
    b, s = a.shape[:2]
    return jnp.moveaxis(a.reshape(b, s // Q_BLOCK, Q_BLOCK, *a.shape[2:]), 1, 0)


def _from_blocks(a):
    nb, b = a.shape[:2]
    return jnp.moveaxis(a, 0, 1).reshape(b, nb * Q_BLOCK, *a.shape[3:])


def _diff_attention(h, pos, cid, w_in, qk_norm, lam, subln, lambda_init, rel_bias):
    bsz, t, _ = h.shape
    q, k, v = jnp.split(h @ w_in, [2 * A_HEADS * A_HD, 4 * A_HEADS * A_HD], axis=-1)
    q = _rms_norm(q.reshape(bsz, t, A_HEADS, 2, A_HD), qk_norm[0])
    k = _rms_norm(k.reshape(bsz, t, A_HEADS, 2, A_HD), qk_norm[1])
    v = v.reshape(bsz, t, A_HEADS, A_VD)
    lf = lam.astype(jnp.float32)
    lam_full = jnp.exp(jnp.dot(lf[0], lf[1])) - jnp.exp(jnp.dot(lf[2], lf[3])) + lambda_init
    scale = A_HD ** -0.5

    def block(qb, qpos):
        nq = qpos.shape[0]
        bias = _rel_bias(rel_bias, pos[None, :] - qpos[:, None])
        bias = bias.reshape(nq, t, 2, A_HEADS).transpose(2, 3, 0, 1)
        logits = jnp.einsum("bqhmd,bkhmd->bmhqk", qb, k).astype(jnp.float32) * scale + bias
        visible = cid[None, :] <= _chunk_id(qpos)[:, None]
        p = jax.nn.softmax(jnp.where(visible, logits, NEG_INF), axis=-1)
        pd = p[:, 0] - lam_full * p[:, 1]
        return jnp.einsum("bhqk,bkhe->bqhe", pd.astype(v.dtype), v)

    o_meta = block(q[:, :N_META], pos[:N_META])
    o_real = _from_blocks(lax.map(lambda a: block(*a),
                                  (_to_blocks(q[:, N_META:]), pos[N_META:].reshape(-1, Q_BLOCK))))
    o = jnp.concatenate([o_meta, o_real], axis=1)
    o = _rms_norm(o, subln) * (1.0 - lambda_init)
    return o.reshape(bsz, t, A_HEADS * A_VD)


def _dsa_attention(h, pos, cid, w_in, latent_norm, w_uq, q_norm, w_uv, rel_bias, k_sel):
    bsz, t, _ = h.shape
    c_q, c_kv, k_idx, w_idx = jnp.split(
        h @ w_in, [B_Q_RANK, B_Q_RANK + B_KV_RANK, B_Q_RANK + B_KV_RANK + IDX_DIM], axis=-1)
    c_q = _rms_norm(c_q, latent_norm[0])
    c_kv = _rms_norm(c_kv, latent_norm[1])
    q_abs, q_idx = jnp.split(c_q @ w_uq, [B_HEADS * B_KV_RANK], axis=-1)
    q_abs = _rms_norm(q_abs.reshape(bsz, t, B_HEADS, B_KV_RANK), q_norm)
    q_idx = q_idx.reshape(bsz, t, IDX_HEADS, IDX_DIM)
    k_idx = _rms_norm(k_idx)
    w_idx = w_idx * IDX_HEADS ** -0.5
    gather = jax.vmap(lambda src, idx: src[idx])

    def block(qa, qi, wi, qpos):
        cid_q = _chunk_id(qpos)
        act = jax.nn.relu(jnp.einsum("bqhd,bsd->bqhs", qi, k_idx) * IDX_DIM ** -0.5)
        score = jnp.einsum("bqh,bqhs->bqs", wi, act).astype(jnp.float32)
        score = jnp.where(cid[None, :] <= cid_q[:, None], score, NEG_INF)
        _, sel = lax.top_k(score, k_sel)
        kv = gather(c_kv, sel)
        valid = cid[sel] <= cid_q[None, :, None]
        bias = _rel_bias(rel_bias, pos[sel] - qpos[None, :, None])
        logits = (jnp.einsum("bqhr,bqkr->bqhk", qa, kv).astype(jnp.float32) * B_KV_RANK ** -0.5
                  + jnp.swapaxes(bias, -1, -2))
        p = jax.nn.softmax(jnp.where(valid[:, :, None, :], logits, NEG_INF), axis=-1)
        o_lat = jnp.einsum("bqhk,bqkr->bqhr", p.astype(kv.dtype), kv)
        o = jnp.einsum("bqhr,hrd->bqhd", o_lat, w_uv)
        return o.reshape(o.shape[0], o.shape[1], B_HEADS * B_VD)

    o_meta = block(q_abs[:, :N_META], q_idx[:, :N_META], w_idx[:, :N_META], pos[:N_META])
    o_real = _from_blocks(lax.map(lambda a: block(*a),
                                  (_to_blocks(q_abs[:, N_META:]), _to_blocks(q_idx[:, N_META:]),
                                   _to_blocks(w_idx[:, N_META:]), pos[N_META:].reshape(-1, Q_BLOCK))))
    return jnp.concatenate([o_meta, o_real], axis=1)


def _swa_attention(h, w_in, qk_norm, sinks, rel_bias):
    bsz, t, _ = h.shape
    q, k, v = jnp.split(h @ w_in, [C_Q_HEADS * C_HD, (C_Q_HEADS + C_KV_HEADS) * C_HD], axis=-1)
    q = _rms_norm(q.reshape(bsz, t, C_Q_HEADS, C_HD), qk_norm[0])
    k = _rms_norm(k.reshape(bsz, t, C_KV_HEADS, C_HD), qk_norm[1])
    v = v.reshape(bsz, t, C_KV_HEADS, C_HD)
    sink = sinks.astype(jnp.float32).reshape(C_KV_HEADS, C_GROUP, 1, 1)

    def attend(qb, kb, vb, qpos, kpos, visible):
        nq, nk = qb.shape[1], kb.shape[1]
        bias = _rel_bias(rel_bias, kpos[None, :] - qpos[:, None])
        bias = bias.transpose(2, 0, 1).reshape(C_KV_HEADS, C_GROUP, nq, nk)
        qg = qb.reshape(bsz, nq, C_KV_HEADS, C_GROUP, C_HD)
        logits = jnp.einsum("bqgjd,bkgd->bgjqk", qg, kb).astype(jnp.float32) * C_HD ** -0.5 + bias
        logits = jnp.where(visible, logits, NEG_INF)
        logits = jnp.concatenate([logits, jnp.broadcast_to(sink, logits.shape[:-1] + (1,))], axis=-1)
        p = jax.nn.softmax(logits, axis=-1)[..., :-1]
        o = jnp.einsum("bgjqk,bkgd->bqgjd", p.astype(vb.dtype), vb)
        return o.reshape(bsz, nq, C_Q_HEADS * C_HD)

    meta_pos = jnp.arange(N_META)
    o_meta = attend(q[:, :N_META], k[:, :N_META], v[:, :N_META], meta_pos, meta_pos,
                    jnp.ones((N_META, N_META), dtype=bool))
    pad = ((0, 0), (C_BEHIND, 0), (0, 0), (0, 0))
    k_pad = jnp.pad(k[:, N_META:], pad)
    v_pad = jnp.pad(v[:, N_META:], pad)
    band = Q_BLOCK + C_BEHIND

    def real_block(qb, blk):
        start = blk * Q_BLOCK
        fq = start + jnp.arange(Q_BLOCK)
        fk = start - C_BEHIND + jnp.arange(band)
        kb = jnp.concatenate([k[:, :N_META], lax.dynamic_slice_in_dim(k_pad, start, band, axis=1)], axis=1)
        vb = jnp.concatenate([v[:, :N_META], lax.dynamic_slice_in_dim(v_pad, start, band, axis=1)], axis=1)
        cq, ck = fq // CHUNK, fk // CHUNK
        in_window = ((fk[None, :] >= 0) & (ck[None, :] <= cq[:, None])
                     & (ck[None, :] >= cq[:, None] - WINDOW_CHUNKS))
        visible = jnp.concatenate([jnp.ones((Q_BLOCK, N_META), dtype=bool), in_window], axis=1)
        kpos = jnp.concatenate([meta_pos, N_META + fk])
        return attend(qb, kb, vb, N_META + fq, kpos, visible)

    nblk = (t - N_META) // Q_BLOCK
    o_real = _from_blocks(lax.map(lambda a: real_block(*a), (_to_blocks(q[:, N_META:]), jnp.arange(nblk))))
    return jnp.concatenate([o_meta, o_real], axis=1)


def setup_inputs(seed: int = 0) -> dict:
    key = jax.random.key(seed)
    ks = iter(jax.random.split(key, 32))
    f32 = jnp.float32
    n_a = len(range(0, DEPTH, N_MIXERS))
    n_b = len(range(1, DEPTH, N_MIXERS))
    n_c = len(range(2, DEPTH, N_MIXERS))

    def w(shape, fan_in):
        return jax.random.normal(next(ks), shape, f32) * fan_in ** -0.5

    def gain(shape):
        return 1.0 + 0.05 * jax.random.normal(next(ks), shape, f32)

    def rnd(shape, s):
        return s * jax.random.normal(next(ks), shape, f32)

    return {
        "x": jax.random.normal(next(ks), (BATCH, SEQ, D_MODEL), f32),
        "meta_tokens": rnd((N_META, D_MODEL), 1.0),
        "rel_bias": rnd((REL_BUCKETS, REL_HEADS), 0.5),
        "ln_ffn1": gain((DEPTH, D_MODEL)),
        "ffn1_wi": w((DEPTH, D_MODEL, 2 * D_FF), D_MODEL),
        "ffn1_wo": w((DEPTH, D_FF, D_MODEL), D_FF),
        "ln_mix": gain((DEPTH, D_MODEL)),
        "w_out": w((DEPTH, D_MODEL, D_MODEL), D_MODEL),
        "ln_ffn2": gain((DEPTH, D_MODEL)),
        "ffn2_wi": w((DEPTH, D_MODEL, 2 * D_FF), D_MODEL),
        "ffn2_wo": w((DEPTH, D_FF, D_MODEL), D_FF),
        "a_w_in": w((n_a, D_MODEL, 4 * A_HEADS * A_HD + A_HEADS * A_VD), D_MODEL),
        "a_qk_norm": gain((n_a, 2, A_HD)),
        "a_lambda": rnd((n_a, 4, A_HD), 0.1),
        "a_subln": gain((n_a, A_VD)),
        "b_w_in": w((n_b, D_MODEL, B_Q_RANK + B_KV_RANK + IDX_DIM + IDX_HEADS), D_MODEL),
        "b_latent_norm": gain((n_b, 2, B_KV_RANK)),
        "b_w_uq": w((n_b, B_Q_RANK, B_HEADS * B_KV_RANK + IDX_HEADS * IDX_DIM), B_Q_RANK),
        "b_q_norm": gain((n_b, B_KV_RANK)),
        "b_w_uv": w((n_b, B_HEADS, B_KV_RANK, B_VD), B_KV_RANK),
        "c_w_in": w((n_c, D_MODEL, (C_Q_HEADS + 2 * C_KV_HEADS) * C_HD), D_MODEL),
        "c_qk_norm": gain((n_c, 2, C_HD)),
        "c_sinks": rnd((n_c, C_Q_HEADS), 0.5),
    }


def reference(x, meta_tokens, rel_bias, ln_ffn1, ffn1_wi, ffn1_wo, ln_mix, w_out, ln_ffn2, ffn2_wi,
              ffn2_wo, a_w_in, a_qk_norm, a_lambda, a_subln, b_w_in, b_latent_norm, b_w_uq, b_q_norm,
              b_w_uv, c_w_in, c_qk_norm, c_sinks):
    bsz, s, d = x.shape
    k_sel = min(TOPK_MAX, s // 4)
    t = N_META + s
    pos = jnp.arange(t)
    cid = _chunk_id(pos)
    h = jnp.concatenate([jnp.broadcast_to(meta_tokens.astype(x.dtype), (bsz, N_META, d)), x], axis=1)
    for layer in range(DEPTH):
        h = h + 0.5 * _swiglu(_rms_norm(h, ln_ffn1[layer]), ffn1_wi[layer], ffn1_wo[layer])
        hn = _rms_norm(h, ln_mix[layer])
        kind, j = layer % N_MIXERS, layer // N_MIXERS
        if kind == 0:
            lambda_init = 0.8 - 0.6 * math.exp(-0.3 * layer)
            mix = _diff_attention(hn, pos, cid, a_w_in[j], a_qk_norm[j], a_lambda[j], a_subln[j],
                                  lambda_init, rel_bias)
        elif kind == 1:
            mix = _dsa_attention(hn, pos, cid, b_w_in[j], b_latent_norm[j], b_w_uq[j], b_q_norm[j],
                                 b_w_uv[j], rel_bias, k_sel)
        else:
            mix = _swa_attention(hn, c_w_in[j], c_qk_norm[j], c_sinks[j], rel_bias)
        h = h + mix @ w_out[layer]
        h = h + 0.5 * _swiglu(_rms_norm(h, ln_ffn2[layer]), ffn2_wi[layer], ffn2_wo[layer])
    return h[:, N_META:]
```

```cpp
#include <hip/hip_runtime.h>
#include <hip/hip_cooperative_groups.h>
#include <cstdio>
namespace cg = cooperative_groups;

#define DI __device__ __forceinline__
typedef unsigned short u16;
typedef __attribute__((ext_vector_type(8))) short bf16x8;
typedef __attribute__((ext_vector_type(4))) short s16x4;
typedef __attribute__((ext_vector_type(16))) float f32x16;
typedef __attribute__((ext_vector_type(4))) float f32x4;
typedef __attribute__((ext_vector_type(2))) float f32x2;
typedef __attribute__((ext_vector_type(2))) __bf16 bf16x2;
typedef __attribute__((ext_vector_type(4))) unsigned u32x4;
typedef __attribute__((ext_vector_type(2))) unsigned u32x2;

constexpr int BATCH = 8, T = 2064, D = 1024, M = BATCH * T, DFF = 2816;
constexpr int SROW = 2080;

constexpr size_t OFF_H = 0;
constexpr size_t OFF_HB = OFF_H + (size_t)M * D * 4;
constexpr size_t OFF_W = OFF_HB + (size_t)M * D * 2;
constexpr size_t W_WI1 = 0, W_WO1 = 11534336, W_WI2 = 17301504, W_WO2 = 28835840, W_OUT = 34603008, W_MIX = 36700160;
constexpr size_t W_TOTAL = 42991616;
constexpr size_t OFF_AR = OFF_W + W_TOTAL;
constexpr size_t AR_ACT = 0;
constexpr size_t AR_QKV = 0;
constexpr size_t AR_O_AC = 101449728;
constexpr size_t AR_BIG = 0;
constexpr size_t AR_O_B = 137379840;
constexpr size_t AR_CQ = 171196416;
constexpr size_t AR_CKV = 179650560;
constexpr size_t AR_KIDX = 188104704;
constexpr size_t AR_WIDX = 190218240;
constexpr size_t AR_QIDX = 190746624;
constexpr size_t AR_SEL = 207654912;
constexpr size_t AR_SSQ = 224563200;
constexpr size_t OFF_BAR = OFF_AR + 226676736;
constexpr size_t WS_NEED = OFF_BAR + 16384;

constexpr int NT = 512;
constexpr int SMEM_BYTES = 4 * 256 * 144 + 1024;

struct Params {
  const float *x, *meta, *relb, *ln1, *wi1, *wo1, *lnm, *wout, *ln2, *wi2, *wo2;
  const float *a_win, *a_qkn, *a_lam, *a_sub, *b_win, *b_lat, *b_wuq, *b_qn, *b_wuv, *c_win, *c_qkn, *c_sink;
  float* out;
  char* ws;
};

#define MK4(a, b, c, d) ((u32x4){(a), (b), (c), (d)})
#define MK2(a, b) ((u32x2){(a), (b)})
DI unsigned pack2(float a, float b) {
  f32x2 v = {a, b};
  bf16x2 r = __builtin_convertvector(v, bf16x2);
  return __builtin_bit_cast(unsigned, r);
}
DI float dot2sq(unsigned v, float c) { bf16x2 a = __builtin_bit_cast(bf16x2, v); return __builtin_amdgcn_fdot2_f32_bf16(a, a, c, false); }
DI float bflo(unsigned v) { return __uint_as_float(v << 16); }
DI float bfhi(unsigned v) { return __uint_as_float(v & 0xffff0000u); }
DI int opaque_tid() { int t = threadIdx.x; asm volatile("" : "+v"(t)); return t; }
DI float shx(float v, int mask, int lane) { return __int_as_float(__builtin_amdgcn_ds_bpermute((lane ^ mask) << 2, __float_as_int(v))); }
DI int shfl_i(int v, int src) { return __builtin_amdgcn_ds_bpermute(src << 2, v); }
DI void lds_barrier() { asm volatile("s_waitcnt lgkmcnt(0)\n\ts_barrier" ::: "memory"); }
DI int crow(int i, int hh) { return (i & 3) + 8 * (i >> 2) + 4 * hh; }
DI f32x16 mfma32(bf16x8 a, bf16x8 b, f32x16 c) { return __builtin_amdgcn_mfma_f32_32x32x16_bf16(a, b, c, 0, 0, 0); }
DI f32x4 mfma16(bf16x8 a, bf16x8 b, f32x4 c) { return __builtin_amdgcn_mfma_f32_16x16x32_bf16(a, b, c, 0, 0, 0); }
DI s16x4 tr_read(const char* p) {
  return __builtin_amdgcn_ds_read_tr16_b64_v4i16((s16x4 __attribute__((address_space(3)))*)(unsigned)(size_t)p);
}
DI bf16x8 cat8(s16x4 lo, s16x4 hi) { return __builtin_shufflevector(lo, hi, 0, 1, 2, 3, 4, 5, 6, 7); }
DI bf16x8 mk8(unsigned a, unsigned b, unsigned c, unsigned d) {
  u32x4 u = MK4(a, b, c, d);
  return __builtin_bit_cast(bf16x8, u);
}
constexpr float LOG2E = 1.4426950408889634f;
DI int t5_bucket(int rel) {
  int n = rel < 0 ? -rel : rel;
  int b = (n < 8 ? n : 8) + (n >= 12) + (n >= 16) + (n >= 23) + (n >= 32) + (n >= 46) + (n >= 64) + (n >= 91);
  return b + (rel > 0 ? 16 : 0);
}
DI float bias_lookup(const float* s_relb, const unsigned char* btab, int rel, int head) {
  const int idx = (rel < -128 ? -128 : (rel > 127 ? 127 : rel)) + 128;
  return s_relb[(int)btab[idx] * 16 + head];
}


#define XB_TMO      128
#define XB_XCNT(j)  (256  + 64 * (j))
#define XB_XSUB(j)  (1280 + 64 * (j))
#define XB_XGEN(j)  (2304 + 64 * (j))
#define XB_TOP      3328
#define XB_TOPGEN   3392
#define XCD_BAR_WORDS 3456
#define XB_SPIN_CAP (1u << 22)
#define LAS __attribute__((address_space(3)))
DI unsigned xb_ld(unsigned* p) { return __hip_atomic_load(p, __ATOMIC_RELAXED, __HIP_MEMORY_SCOPE_AGENT); }
DI unsigned xb_add(unsigned* p, unsigned v) { return __hip_atomic_fetch_add(p, v, __ATOMIC_RELAXED, __HIP_MEMORY_SCOPE_AGENT); }
DI unsigned xb_xcc_id() { return (unsigned)__builtin_amdgcn_s_getreg((3 << 11) | 20) & 0xFu; }
#define XB_SPIN(cond, bar) do { unsigned _sp = 0; while (cond) { __builtin_amdgcn_s_sleep(1); \
    if ((++_sp & 255u) == 0u) { if (xb_ld(&(bar)[XB_TMO])) break; if (_sp > XB_SPIN_CAP) { atomicAdd(&(bar)[XB_TMO], 1u); break; } } } } while (0)
struct XcdBarrier { unsigned* bar; unsigned x; volatile LAS unsigned* st; };
DI XcdBarrier xcd_barrier_post(unsigned* bar, volatile LAS unsigned* st) {
  XcdBarrier b; b.bar = bar; b.x = xb_xcc_id(); b.st = st;
  if (threadIdx.x == 0) (void)xb_add(&bar[XB_XCNT(b.x)], 1u);
  return b;
}
DI void xcd_barrier_complete(unsigned* bar, unsigned x, unsigned& nloc, unsigned& nx) {
  const unsigned G = gridDim.x * gridDim.y * gridDim.z;
  unsigned sum, cnt, mine, sp = 0u;
  for (;;) {
    sum = 0u; cnt = 0u; mine = 0u;
#pragma unroll
    for (unsigned j = 0; j < 16; ++j) { const unsigned c = xb_ld(&bar[XB_XCNT(j)]); sum += c; cnt += (c > 0u) ? 1u : 0u; mine = (j == x) ? c : mine; }
    if (sum == G) break;
    __builtin_amdgcn_s_sleep(1);
    if ((++sp & 255u) == 0u) { if (xb_ld(&bar[XB_TMO])) break; if (sp > XB_SPIN_CAP) { atomicAdd(&bar[XB_TMO], 1u); break; } }
  }
  nloc = mine > 0u ? mine : 1u; nx = cnt > 0u ? cnt : 1u;
}
DI void xcd_barrier(const XcdBarrier& b) {
  asm volatile("s_waitcnt vmcnt(0)" ::: "memory");
  __syncthreads();
  if (threadIdx.x == 0) {
    unsigned* bar = b.bar;
    __builtin_amdgcn_s_waitcnt(0);
    unsigned nloc = b.st[0], nx = b.st[1];
    if (nloc == 0u) { xcd_barrier_complete(bar, b.x, nloc, nx); b.st[0] = nloc; b.st[1] = nx; }
    const unsigned old = xb_add(&bar[XB_XSUB(b.x)], 1u);
    const unsigned gen = old / nloc;
    if (old + 1u == (gen + 1u) * nloc) {
      __builtin_amdgcn_fence(__ATOMIC_RELEASE, "agent");
      asm volatile("s_waitcnt vmcnt(0)" ::: "memory");
      const unsigned og = xb_add(&bar[XB_TOP], 1u);
      const unsigned tg = og / nx;
      if (og + 1u == (tg + 1u) * nx) xb_add(&bar[XB_TOPGEN], 1u);
      else XB_SPIN(xb_ld(&bar[XB_TOPGEN]) == tg, bar);
      __builtin_amdgcn_fence(__ATOMIC_ACQUIRE, "agent");
      xb_add(&bar[XB_XGEN(b.x)], 1u);
      asm volatile("s_waitcnt vmcnt(0)" ::: "memory");
    } else {
      XB_SPIN(xb_ld(&bar[XB_XGEN(b.x)]) == gen, bar);
      __builtin_amdgcn_fence(__ATOMIC_ACQUIRE, "agent");
      asm volatile("s_waitcnt vmcnt(0)" ::: "memory");
    }
  }
  __syncthreads();
}

enum { CV_ID = 0, CV_PAD = 1, CV_FFN = 2, CV_UVBD = 3 };
DI float conv_src(const float* src, int ld, int kind, int k, int n) {
  if (kind == CV_ID) return src[(size_t)k * ld + n];
  if (kind == CV_PAD) return n < ld ? src[(size_t)k * ld + n] : 0.f;
  if (kind == CV_FFN) {
    int tile = n >> 7, j = n & 127;
    int col = j < 64 ? tile * 64 + j : DFF + tile * 64 + (j - 64);
    return src[(size_t)k * ld + col];
  }
  int h = n >> 6, d = n & 63;
  return ((k >> 8) == (h & 3)) ? src[((size_t)h * 256 + (k & 255)) * 64 + d] : 0.f;
}
DI void conv_job(const float* src, int ld, int K, int N, int kind, const float* gain, u16* dst, char* smem, int rank, int nwork) {
  float* lds = (float*)smem;
  const int tid = opaque_tid();
  const int tk_n = K >> 7, tn_n = N >> 6;
  if (rank < 0) return;
  for (int tile = rank; tile < tk_n * tn_n; tile += nwork) {
    const int tk = tile % tk_n, tn = tile / tk_n;
    const int k0 = tk * 128, n0 = tn * 64;
    const int nn = tid & 63;
    float cv[16];
#pragma unroll
    for (int i = 0; i < 16; ++i) cv[i] = conv_src(src, ld, kind, k0 + (tid >> 6) + 8 * i, n0 + nn);
    if (gain) {
      float gv[16];
#pragma unroll
      for (int i = 0; i < 16; ++i) gv[i] = gain[k0 + (tid >> 6) + 8 * i];
#pragma unroll
      for (int i = 0; i < 16; ++i) cv[i] *= gv[i];
    }
#pragma unroll
    for (int i = 0; i < 16; ++i) lds[nn * 129 + (tid >> 6) + 8 * i] = cv[i];
    __syncthreads();
    {
      const int n2 = tid >> 3, ks = (tid & 7) * 16;
      const float* r = lds + n2 * 129 + ks;
      u32x4 o0 = MK4(pack2(r[0], r[1]), pack2(r[2], r[3]), pack2(r[4], r[5]), pack2(r[6], r[7]));
      u32x4 o1 = MK4(pack2(r[8], r[9]), pack2(r[10], r[11]), pack2(r[12], r[13]), pack2(r[14], r[15]));
      u32x4* d4 = (u32x4*)(dst + (size_t)(n0 + n2) * K + k0 + ks);
      d4[0] = o0; d4[1] = o1;
    }
    __syncthreads();
  }
}

enum { EPI_SWIGLU = 0, EPI_RESID, EPI_QKV, EPI_B_IN, EPI_QIDX, EPI_QABS, EPI_PLAIN };
struct GemmCfg {
  const u16* A; int lda; int a_koff_tn; const u16* Bt; int K; int N; int epi; int use_rs;
  u16* o16; int ldo;
  const float* gain; int nk_end;
  float* f0; u16* o16b; float* f1;
};

DI void epi_slab(const GemmCfg c, const f32x16 (&acc)[4], float* sW, const float* rss, const size_t row0, const int g, const int lane,
                 float* const g_h, u16* const g_hb, float* const g_out, const int final_out) {
  int ln_ = lane;
  asm volatile("" : "+v"(ln_));
  const int l31 = ln_ & 31, hh = ln_ >> 5;
#pragma unroll
  for (int nb = 0; nb < 4; ++nb)
#pragma unroll
    for (int i = 0; i < 16; ++i) sW[crow(i, hh) * 132 + nb * 32 + l31] = acc[nb][i];
  asm volatile("s_waitcnt lgkmcnt(0)" ::: "memory");
  const int K = c.K;
  const float invK = 1.0f / (float)K;
  if (c.epi == EPI_SWIGLU) {
    const int c4 = (ln_ & 15) * 4;
#pragma unroll 2
    for (int it = 0; it < 8; ++it) {
      const int r = (ln_ >> 4) + 4 * it;
      const float rs = rsqrtf(rss[r] * invK + 1e-6f);
      f32x4 a = *(const f32x4*)(sW + r * 132 + c4);
      f32x4 b = *(const f32x4*)(sW + r * 132 + 64 + c4);
      float y[4];
#pragma unroll
      for (int e = 0; e < 4; ++e) { float av = a[e] * rs, bv = b[e] * rs; y[e] = av * __builtin_amdgcn_rcpf(1.f + __expf(-av)) * bv; }
      *(u32x2*)(c.o16 + (row0 + r) * DFF + g * 64 + c4) = MK2(pack2(y[0], y[1]), pack2(y[2], y[3]));
    }
  } else if (c.epi == EPI_RESID) {
    const int c4 = l31 * 4;
    const int col = g * 128 + c4;
    const float sc = (K == DFF ? 0.5f : 1.f);
#pragma unroll
    for (int hb_ = 0; hb_ < 2; ++hb_) {
      f32x4 hv[8];
#pragma unroll
      for (int i8 = 0; i8 < 8; ++i8) hv[i8] = *(const f32x4*)(g_h + (row0 + hh + 2 * (hb_ * 8 + i8)) * D + col);
#pragma unroll
      for (int i8 = 0; i8 < 8; ++i8) {
        const int r = hh + 2 * (hb_ * 8 + i8);
        const size_t row = row0 + r;
        f32x4 v = *(const f32x4*)(sW + r * 132 + c4);
        f32x4 o = hv[i8] + v * sc;
        *(f32x4*)(g_h + row * D + col) = o;
        *(u32x2*)(g_hb + row * D + col) = MK2(pack2(o[0], o[1]), pack2(o[2], o[3]));
        if (final_out) {
          const int b = (int)(row / T), t = (int)(row % T);
          if (t >= 16) *(f32x4*)(g_out + ((size_t)b * 2048 + (t - 16)) * D + col) = o;
        }
      }
    }
  } else {
    const int c4 = l31 * 4;
    const int col = g * 128 + c4;
#pragma unroll 2
    for (int it = 0; it < 16; ++it) {
      const int r = hh + 2 * it;
      const size_t row = row0 + r;
      f32x4 v = *(const f32x4*)(sW + r * 132 + c4);
      const float rs = c.use_rs ? rsqrtf(rss[r] * invK + 1e-6f) : 1.f;
      if (c.epi == EPI_QKV) {
        f32x4 x = v * rs;
        float s = x[0] * x[0] + x[1] * x[1] + x[2] * x[2] + x[3] * x[3];
        s += shx(s, 1, ln_); s += shx(s, 2, ln_); s += shx(s, 4, ln_); s += shx(s, 8, ln_);
        if (g < c.nk_end) {
          const float r2 = rsqrtf(s * (1.f / 64.f) + 1e-6f) * (g < 8 ? 0.125f * LOG2E : 1.f);
          f32x4 gn = *(const f32x4*)(c.gain + (g < 8 ? 0 : 64) + (c4 & 63));
          x = x * gn * r2;
        }
        *(u32x2*)(c.o16 + row * c.ldo + col) = MK2(pack2(x[0], x[1]), pack2(x[2], x[3]));
      } else if (c.epi == EPI_B_IN) {
        f32x4 x = v * rs;
        float s = x[0] * x[0] + x[1] * x[1] + x[2] * x[2] + x[3] * x[3];
        s += shx(s, 1, ln_); s += shx(s, 2, ln_); s += shx(s, 4, ln_); s += shx(s, 8, ln_);
        if (g < 2) {
          *(u32x2*)(c.o16 + row * 256 + col) = MK2(pack2(x[0], x[1]), pack2(x[2], x[3]));
        } else if (g < 4) {
          *(f32x4*)(c.f0 + row * 256 + (col - 256)) = x;
        } else if (g == 4 && c4 < 64) {
          const float r2 = rsqrtf(s * (1.f / 64.f) + 1e-6f);
          x = x * r2;
          *(u32x2*)(c.o16b + row * 64 + c4) = MK2(pack2(x[0], x[1]), pack2(x[2], x[3]));
        } else if (g == 4 && c4 < 72) {
          *(f32x4*)(c.f1 + row * 8 + (c4 - 64)) = x * 0.35355339059327373f;
        }
      } else if (c.epi == EPI_QIDX) {
        f32x4 x = v * (rs * 0.125f);
        *(u32x2*)(c.o16 + row * 512 + col) = MK2(pack2(x[0], x[1]), pack2(x[2], x[3]));
      } else if (c.epi == EPI_QABS) {
        f32x4 x = v * rs;
        float s = x[0] * x[0] + x[1] * x[1] + x[2] * x[2] + x[3] * x[3];
        s += shx(s, 1, ln_); s += shx(s, 2, ln_); s += shx(s, 4, ln_); s += shx(s, 8, ln_); s += shx(s, 16, ln_);
        if (l31 == 0) c.f0[row * 32 + g] = s;
        *(u32x2*)(c.o16 + row * 4096 + col) = MK2(pack2(x[0], x[1]), pack2(x[2], x[3]));
      } else {
        *(u32x2*)(c.o16 + row * c.ldo + col) = MK2(pack2(v[0], v[1]), pack2(v[2], v[3]));
      }
    }
  }
  asm volatile("s_waitcnt lgkmcnt(0)" ::: "memory");
}

constexpr int GTS = 256 * 144;
DI void gemm_run(const GemmCfg c, char* smem, float* const g_h, u16* const g_hb, float* const g_out, const int final_out) {
  const int tid = opaque_tid(), lane = tid & 63, w = __builtin_amdgcn_readfirstlane(tid >> 6), wm = w >> 1, wn = w & 1;
  const int l31 = lane & 31, hh = lane >> 5;
  float* s_rowss = (float*)(smem + 4 * GTS);
  float* sW = (float*)(smem + w * (32 * 132 * 4));
  const int tilesN = c.N >> 8;
  const int K = c.K, nk = K >> 6;
  const int G = gridDim.x;
  const bool tail16 = (tilesN == 4) && (G == 256) && (c.epi == EPI_RESID || c.epi == EPI_PLAIN);
  const int ntiles = (tail16 ? 64 : 65) * tilesN;
  const int lrow = tid >> 3, lch = tid & 7;
  const int Lb = ((G & 7) == 0) ? (int)(blockIdx.x & 7) * (G >> 3) + (int)(blockIdx.x >> 3) : (int)blockIdx.x;
  const int srow = 8 * tilesN;
  for (int slot = Lb; slot < ntiles; slot += G) {
    const int sr = slot / srow, idx = slot - sr * srow;
    const int tm = sr < 8 ? sr * 8 + (idx & 7) : 64;
    const int tn = sr < 8 ? (idx >> 3) : idx;
    const u16* Ag = c.A + (size_t)(tm * 256 + lrow) * c.lda + tn * c.a_koff_tn + lch * 8;
    const u16* Bg = c.Bt + (size_t)(tn * 256 + lrow) * K + lch * 8;
    const size_t astep = (size_t)64 * c.lda, bstep = (size_t)64 * K;
    f32x16 acc[2][4];
#pragma unroll
    for (int a = 0; a < 2; ++a)
#pragma unroll
      for (int b = 0; b < 4; ++b)
#pragma unroll
        for (int i = 0; i < 16; ++i) acc[a][b][i] = 0.f;
    float ss[4] = {0.f, 0.f, 0.f, 0.f};
    u32x4 ra0[4], rb0[4];
#define G_LOAD(RA, RB, KT) { size_t as_ = astep, bs_ = bstep; asm volatile("" : "+s"(as_), "+s"(bs_)); \
      _Pragma("unroll") for (int i = 0; i < 4; ++i) { RA[i] = *(const u32x4*)(Ag + i * as_ + (KT) * 64); RB[i] = *(const u32x4*)(Bg + i * bs_ + (KT) * 64); } }
#define G_STORE(RA, RB, BUF) { _Pragma("unroll") for (int i = 0; i < 4; ++i) { \
      *(u32x4*)(smem + (BUF) * GTS + (lrow + 64 * i) * 144 + lch * 16) = RA[i]; \
      *(u32x4*)(smem + 2 * GTS + (BUF) * GTS + (lrow + 64 * i) * 144 + lch * 16) = RB[i]; } \
      _Pragma("unroll") for (int i = 0; i < 4; ++i) \
        ss[i] = dot2sq(RA[i][3], dot2sq(RA[i][2], dot2sq(RA[i][1], dot2sq(RA[i][0], ss[i])))); }
#define K_FRAG(S, FA, FB) { \
        _Pragma("unroll") for (int q_ = 0; q_ < 2; ++q_) FA[q_] = *(const bf16x8*)(sAc + (wm * 64 + q_ * 32 + l31) * 144 + (2 * (S) + hh) * 16); \
        _Pragma("unroll") for (int q_ = 0; q_ < 4; ++q_) FB[q_] = *(const bf16x8*)(sBc + (wn * 128 + q_ * 32 + l31) * 144 + (2 * (S) + hh) * 16); }
#define K_STEP(CUR, NXT, KTL, DOSTORE, DOLOAD) { \
      const char* sAc = smem + (CUR) * GTS; const char* sBc = smem + 2 * GTS + (CUR) * GTS; \
      size_t as_ = astep, bs_ = bstep; asm volatile("" : "+s"(as_), "+s"(bs_)); \
      _Pragma("unroll") for (int s = 0; s < 4; ++s) { \
        bf16x8 fa[1][2], fb[1][4]; \
        K_FRAG(s, fa[0], fb[0]); \
        if (DOSTORE) { \
          *(u32x4*)(smem + (NXT) * GTS + (lrow + 64 * s) * 144 + lch * 16) = ra0[s]; \
          *(u32x4*)(smem + 2 * GTS + (NXT) * GTS + (lrow + 64 * s) * 144 + lch * 16) = rb0[s]; \
          ss[s] = dot2sq(ra0[s][3], dot2sq(ra0[s][2], dot2sq(ra0[s][1], dot2sq(ra0[s][0], ss[s])))); } \
        if (DOLOAD) { ra0[s] = *(const u32x4*)(Ag + s * as_ + (KTL) * 64); rb0[s] = *(const u32x4*)(Bg + s * bs_ + (KTL) * 64); } \
        _Pragma("unroll") for (int mb = 0; mb < 2; ++mb) \
          _Pragma("unroll") for (int nb = 0; nb < 4; ++nb) acc[mb][nb] = mfma32(fa[0][mb], fb[0][nb], acc[mb][nb]); \
        __builtin_amdgcn_sched_group_barrier(0x100, 6, 0); \
        __builtin_amdgcn_sched_group_barrier(0x008, 1, 0); __builtin_amdgcn_sched_group_barrier(0x200, 1, 0); \
        __builtin_amdgcn_sched_group_barrier(0x008, 1, 0); __builtin_amdgcn_sched_group_barrier(0x200, 1, 0); \
        __builtin_amdgcn_sched_group_barrier(0x008, 1, 0); __builtin_amdgcn_sched_group_barrier(0x002, 4, 0); \
        __builtin_amdgcn_sched_group_barrier(0x008, 1, 0); __builtin_amdgcn_sched_group_barrier(0x020, 1, 0); \
        __builtin_amdgcn_sched_group_barrier(0x008, 1, 0); __builtin_amdgcn_sched_group_barrier(0x020, 1, 0); \
        __builtin_amdgcn_sched_group_barrier(0x008, 3, 0); \
        __builtin_amdgcn_sched_barrier(0); } }
    G_LOAD(ra0, rb0, 0);
    __syncthreads();
    G_STORE(ra0, rb0, 0);
    G_LOAD(ra0, rb0, 1);
    lds_barrier();
    int kt = 0;
    for (; kt + 3 < nk; kt += 2) {
      K_STEP(0, 1, kt + 2, true, true);
      lds_barrier();
      K_STEP(1, 0, kt + 3, true, true);
      lds_barrier();
    }
    K_STEP(0, 1, 0, true, false);
    lds_barrier();
    K_STEP(1, 0, 0, false, false);
    lds_barrier();
#undef K_STEP
#undef K_FRAG
#undef G_LOAD
#undef G_STORE
    if (c.use_rs) {
#pragma unroll
      for (int i = 0; i < 4; ++i) {
        float s_ = ss[i];
        s_ += shx(s_, 1, lane); s_ += shx(s_, 2, lane); s_ += shx(s_, 4, lane);
        if (lch == 0) s_rowss[lrow + 64 * i] = s_;
      }
    }
    __syncthreads();
#pragma unroll
    for (int mb = 0; mb < 2; ++mb) {
      const size_t row0 = (size_t)tm * 256 + wm * 64 + mb * 32;
      if (row0 < (size_t)M) epi_slab(c, acc[mb], sW, s_rowss + wm * 64 + mb * 32, row0, tn * 2 + wn, lane, g_h, g_hb, g_out, final_out);
    }
  }
  __syncthreads();
  if (tail16) {
    float* sP = (float*)smem;
    const int l15 = lane & 15, kq = lane >> 4;
    const int Kw = K >> 3;
    for (int t = (int)blockIdx.x; t < 512; t += G) {
      const int rg = t & 7, cg = t >> 3;
      const u16* Ap = c.A + (size_t)(16384 + rg * 16 + l15) * c.lda + (cg >> 4) * c.a_koff_tn + w * Kw + kq * 8;
      const u16* Bp = c.Bt + (size_t)(cg * 16 + l15) * K + w * Kw + kq * 8;
      f32x4 a4 = {0.f, 0.f, 0.f, 0.f};
#pragma unroll 4
      for (int k = 0; k < Kw; k += 32) {
        bf16x8 av = *(const bf16x8*)(Ap + k);
        bf16x8 bv = *(const bf16x8*)(Bp + k);
        a4 = mfma16(av, bv, a4);
      }
#pragma unroll
      for (int i = 0; i < 4; ++i) sP[w * 256 + (kq * 4 + i) * 16 + l15] = a4[i];
      __syncthreads();
      if (tid < 256) {
        const float v = ((sP[tid] + sP[256 + tid]) + (sP[512 + tid] + sP[768 + tid])) + ((sP[1024 + tid] + sP[1280 + tid]) + (sP[1536 + tid] + sP[1792 + tid]));
        const size_t row = 16384 + rg * 16 + (tid >> 4);
        const int col = cg * 16 + (tid & 15);
        if (c.epi == EPI_RESID) {
          const float o = g_h[row * D + col] + v * (K == DFF ? 0.5f : 1.f);
          g_h[row * D + col] = o;
          g_hb[row * D + col] = (u16)(pack2(o, o) & 0xffffu);
          if (final_out) {
            const int b = (int)(row / T), t2 = (int)(row % T);
            if (t2 >= 16) g_out[((size_t)b * 2048 + (t2 - 16)) * D + col] = o;
          }
        } else {
          c.o16[row * c.ldo + col] = (u16)(pack2(v, v) & 0xffffu);
        }
      }
      __syncthreads();
    }
  }
  __syncthreads();
}

template <int VD, bool DIFF>
DI void attn_dense(const Params& p, const u16* qkv, int ld, u16* o, const float* lam4, const float* subln,
                           float lam_init, const float* sinks, char* smem) {
  constexpr int VS = VD * 2 + 64;
  constexpr int NDB = VD / 32;
  constexpr int NVL = VD / 64;
  constexpr int TB = 9216 + 64 * VS;
  float* s_relb = (float*)(smem + 2 * TB);
  const int tid = opaque_tid(), lane = tid & 63, w = __builtin_amdgcn_readfirstlane(tid >> 6);
  unsigned* s_stash = (unsigned*)(smem + 2 * TB + 2048) + w * 2048 + lane;
  const int l31 = lane & 31, hh = lane >> 5;
  const int q4 = (lane & 15) >> 2, p4 = lane & 3, blk = (lane >> 4) & 1;
  unsigned char* s_btab = (unsigned char*)(smem + 2 * TB + 2048 + 65536);
  if (tid < 512) s_relb[tid] = p.relb[tid] * LOG2E;
  if (tid < 256) s_btab[tid] = (unsigned char)t5_bucket(tid - 128);
  float lam_full = 0.f;
  if (DIFF) {
    float v1 = lam4[lane] * lam4[64 + lane], v2 = lam4[128 + lane] * lam4[192 + lane];
#pragma unroll
    for (int o_ = 32; o_ >= 1; o_ >>= 1) { v1 += shx(v1, o_, lane); v2 += shx(v2, o_, lane); }
    lam_full = __expf(v1) - __expf(v2) + lam_init;
  }
  __syncthreads();
  constexpr int NH = DIFF ? 8 : 16;
  const int nitems = DIFF ? (256 + 64) : (BATCH * NH * 9);
  for (int item = blockIdx.x; item < nitems; item += gridDim.x) {
    int b, hd, qb0, nrep;
    if (DIFF) {
      if (item < 256) { const int pi = item >> 6; b = (item >> 3) & 7; hd = item & 7; qb0 = 8 - pi; nrep = 2; }
      else { const int r = item - 256; b = r >> 3; hd = r & 7; qb0 = 0; nrep = 1; }
    } else {
      qb0 = 8 - item / (BATCH * NH); const int r = item % (BATCH * NH); b = r / NH; hd = r % NH; nrep = 1;
    }
    for (int rep = 0; rep < nrep; ++rep) {
      const int qb = rep == 0 ? qb0 : 9 - qb0;
      const int qbase = qb == 0 ? 32 * w : 16 + 256 * (qb - 1) + 32 * w;
      const int cq_w = qb == 0 ? 0 : 4 * (qb - 1) + 1 + (w >> 1);
      const int cq_max = qb == 0 ? 0 : 4 * qb;
      const int jlo_blk = DIFF ? 1 : (qb == 0 ? 1 : (4 * qb - 5 > 1 ? 4 * qb - 5 : 1));
      const int jlo_w = DIFF ? 1 : (cq_w - 2 > 1 ? cq_w - 2 : 1);
      const int ntl = 1 + (cq_max >= jlo_blk ? cq_max - jlo_blk + 1 : 0);
      const size_t qrow = (size_t)b * T + qbase + l31;
      const int vcol = DIFF ? 2048 + hd * 128 : 1152 + (hd >> 3) * 64;
      for (int mm = 0; mm < (DIFF ? 2 : 1); ++mm) {
        const int qcol = DIFF ? hd * 128 + mm * 64 : hd * 64;
        const int kcol = DIFF ? 1024 + hd * 128 + mm * 64 : 1024 + (hd >> 3) * 64;
        const int bh = DIFF ? mm * 8 + hd : hd;
        bf16x8 qf[4];
#pragma unroll
        for (int s = 0; s < 4; ++s) qf[s] = *(const bf16x8*)(qkv + qrow * ld + qcol + 16 * s + 8 * hh);
        f32x16 O[NDB];
#pragma unroll
        for (int d_ = 0; d_ < NDB; ++d_)
#pragma unroll
          for (int i = 0; i < 16; ++i) O[d_][i] = 0.f;
        float l = 0.f;
        const float bfar = s_relb[15 * 16 + bh];
        const int lkey = tid >> 3;
        u32x4 rk, rv[NVL];
        {
          const size_t krow = (size_t)b * T + lkey;
          rk = *(const u32x4*)(qkv + krow * ld + kcol + (tid & 7) * 8);
#pragma unroll
          for (int c_ = 0; c_ < NVL; ++c_) rv[c_] = *(const u32x4*)(qkv + krow * ld + vcol + ((tid & 7) * NVL + c_) * 8);
        }
        __syncthreads();
        {
          char* sK0 = smem; char* sV0 = smem + 9216;
          *(u32x4*)(sK0 + lkey * 144 + (tid & 7) * 16) = rk;
#pragma unroll
          for (int c_ = 0; c_ < NVL; ++c_) *(u32x4*)(sV0 + lkey * VS + ((tid & 7) * NVL + c_) * 16) = rv[c_];
        }
        lds_barrier();
        for (int tt = 0; tt < ntl; ++tt) {
          const char* sK = smem + (tt & 1) * TB;
          const char* sV = sK + 9216;
          if (tt + 1 < ntl) {
            const int kst = 16 + 64 * (jlo_blk + tt - 1);
            const size_t krow = (size_t)b * T + kst + lkey;
            rk = *(const u32x4*)(qkv + krow * ld + kcol + (tid & 7) * 8);
#pragma unroll
            for (int c_ = 0; c_ < NVL; ++c_) rv[c_] = *(const u32x4*)(qkv + krow * ld + vcol + ((tid & 7) * NVL + c_) * 8);
          }
          __builtin_amdgcn_sched_barrier(0);
          const int j = jlo_blk + tt - 1;
          const bool active = (tt == 0) || (j >= jlo_w && j <= cq_w);
          if (active) {
            const int start = tt == 0 ? 0 : 16 + 64 * (j - 1);
            const int valid = tt == 0 ? 16 : 64;
            const int qpos = qbase + l31;
            const bool far = (start + 63 - qbase) <= -91;
#pragma unroll
            for (int kb = 0; kb < 2; ++kb) {
              f32x16 S;
#pragma unroll
              for (int i = 0; i < 16; ++i) S[i] = 0.f;
#pragma unroll
              for (int s = 0; s < 4; ++s) {
                bf16x8 a = *(const bf16x8*)(sK + (32 * kb + l31) * 144 + (2 * s + hh) * 16);
                S = mfma32(a, qf[s], S);
              }
              if (far) {
#pragma unroll
                for (int i = 0; i < 16; ++i) S[i] = __builtin_amdgcn_exp2f(S[i] + bfar);
              } else {
#pragma unroll
                for (int i = 0; i < 16; ++i) {
                  const int kl = 32 * kb + crow(i, hh);
                  S[i] = __builtin_amdgcn_exp2f(S[i] + bias_lookup(s_relb, s_btab, start + kl - qpos, bh));
                }
              }
              if (valid < 64) {
#pragma unroll
                for (int i = 0; i < 16; ++i) {
                  const int kl = 32 * kb + crow(i, hh);
                  S[i] = kl < valid ? S[i] : 0.f;
                }
              }
#pragma unroll
              for (int i = 0; i < 16; ++i) l += S[i];
              bf16x8 pf[2];
#pragma unroll
              for (int s2 = 0; s2 < 2; ++s2)
                pf[s2] = mk8(pack2(S[8 * s2], S[8 * s2 + 1]), pack2(S[8 * s2 + 2], S[8 * s2 + 3]),
                             pack2(S[8 * s2 + 4], S[8 * s2 + 5]), pack2(S[8 * s2 + 6], S[8 * s2 + 7]));
#pragma unroll
              for (int d_ = 0; d_ < NDB; ++d_) {
#pragma unroll
                for (int s2 = 0; s2 < 2; ++s2) {
                  const int k0 = 32 * kb + 16 * s2 + 4 * hh + q4;
                  s16x4 lo = tr_read(sV + k0 * VS + (32 * d_ + 16 * blk) * 2 + 8 * p4);
                  s16x4 hi = tr_read(sV + (k0 + 8) * VS + (32 * d_ + 16 * blk) * 2 + 8 * p4);
                  O[d_] = mfma32(cat8(lo, hi), pf[s2], O[d_]);
                }
              }
              __builtin_amdgcn_sched_barrier(0);
            }
          }
          if (tt + 1 < ntl) {
            char* sKn = smem + ((tt + 1) & 1) * TB; char* sVn = sKn + 9216;
            *(u32x4*)(sKn + lkey * 144 + (tid & 7) * 16) = rk;
#pragma unroll
            for (int c_ = 0; c_ < NVL; ++c_) *(u32x4*)(sVn + lkey * VS + ((tid & 7) * NVL + c_) * 16) = rv[c_];
          }
          lds_barrier();
        }
        l += shx(l, 32, lane);
        const bool rowok = qb == 0 ? (w == 0 && l31 < 16) : true;
        if (DIFF) {
          const float inv = 1.f / l;
          if (mm == 0) {
#pragma unroll
            for (int d_ = 0; d_ < NDB; ++d_)
#pragma unroll
              for (int k = 0; k < 8; ++k) s_stash[(d_ * 8 + k) * 64] = pack2(O[d_][2 * k] * inv, O[d_][2 * k + 1] * inv);
          } else {
            float sq = 0.f;
            const float li = lam_full * inv;
#pragma unroll
            for (int d_ = 0; d_ < NDB; ++d_) {
#pragma unroll
              for (int k = 0; k < 8; ++k) {
                const unsigned st_ = s_stash[(d_ * 8 + k) * 64];
                const float x0 = bflo(st_) - li * O[d_][2 * k];
                const float x1 = bfhi(st_) - li * O[d_][2 * k + 1];
                O[d_][2 * k] = x0; O[d_][2 * k + 1] = x1;
                sq = fmaf(x0, x0, sq);
                sq = fmaf(x1, x1, sq);
              }
              __builtin_amdgcn_sched_barrier(0);
            }
            sq += shx(sq, 32, lane);
            const float r = rsqrtf(sq * (1.f / 128.f) + 1e-6f) * (1.f - lam_init);
            if (rowok) {
#pragma unroll
              for (int d_ = 0; d_ < NDB; ++d_) {
#pragma unroll
                for (int g = 0; g < 4; ++g) {
                  const int e = 32 * d_ + 8 * g + 4 * hh;
                  f32x4 sg = *(const f32x4*)(subln + e);
                  u32x2 ov = MK2(pack2(O[d_][4 * g] * r * sg[0], O[d_][4 * g + 1] * r * sg[1]),
                                        pack2(O[d_][4 * g + 2] * r * sg[2], O[d_][4 * g + 3] * r * sg[3]));
                  *(u32x2*)(o + qrow * D + hd * 128 + e) = ov;
                }
                __builtin_amdgcn_sched_barrier(0);
              }
            }
          }
        } else {
          l += __expf(sinks[hd]);
          const float inv = 1.f / l;
          if (rowok) {
#pragma unroll
            for (int d_ = 0; d_ < NDB; ++d_)
#pragma unroll
              for (int g = 0; g < 4; ++g) {
                const int e = 32 * d_ + 8 * g + 4 * hh;
                u32x2 ov = MK2(pack2(O[d_][4 * g] * inv, O[d_][4 * g + 1] * inv),
                                      pack2(O[d_][4 * g + 2] * inv, O[d_][4 * g + 3] * inv));
                *(u32x2*)(o + qrow * D + hd * 64 + e) = ov;
              }
          }
        }
      }
    }
  }
  __syncthreads();
}

DI void kvnorm_pass(const float* raw, const float* g1, u16* ckv) {
  const int tid = opaque_tid();
  const int lane = tid & 63, w = __builtin_amdgcn_readfirstlane(tid >> 6);
  f32x4 g = *(const f32x4*)(g1 + lane * 4);
  for (int row = blockIdx.x * 8 + w; row < M; row += gridDim.x * 8) {
    f32x4 v = *(const f32x4*)(raw + (size_t)row * 256 + lane * 4);
    float s = v[0] * v[0] + v[1] * v[1] + v[2] * v[2] + v[3] * v[3];
#pragma unroll
    for (int o_ = 32; o_ >= 1; o_ >>= 1) s += shx(s, o_, lane);
    const float r = rsqrtf(s * (1.f / 256.f) + 1e-6f);
    v = v * g * r;
    *(u32x2*)(ckv + (size_t)row * 256 + lane * 4) = MK2(pack2(v[0], v[1]), pack2(v[2], v[3]));
  }
}

DI void idx_scores(const u16* kidx, const u16* qidx, const float* widx, float* scores) {
  const int tid = opaque_tid(), lane = tid & 63, w = __builtin_amdgcn_readfirstlane(tid >> 6);
  const int l31 = lane & 31, hh = lane >> 5;
  const int nitems = BATCH * 153;
  for (int item = blockIdx.x; item < nitems; item += gridDim.x) {
    const int b = item / 153, r = item % 153;
    int qb = 0;
    while (qb < 8 && 2 * (qb + 1) * (qb + 1) - (qb + 1) <= r) ++qb;
    const int tt = r - (2 * qb * qb - qb);
    const int qbase = qb == 0 ? 32 * w : 16 + 256 * (qb - 1) + 32 * w;
    const int cq_w = qb == 0 ? 0 : 4 * (qb - 1) + 1 + (w >> 1);
    if (tt > cq_w) continue;
    const int start = tt == 0 ? 0 : 16 + 64 * (tt - 1);
    const int valid = tt == 0 ? 16 : 64;
    const size_t qrow = (size_t)b * T + qbase + l31;
    bf16x8 Kf[2][4];
#pragma unroll
    for (int kb = 0; kb < 2; ++kb)
#pragma unroll
      for (int s = 0; s < 4; ++s)
        Kf[kb][s] = *(const bf16x8*)(kidx + ((size_t)b * T + start + 32 * kb + l31) * 64 + 16 * s + 8 * hh);
    f32x16 acc[2];
#pragma unroll
    for (int kb = 0; kb < 2; ++kb)
#pragma unroll
      for (int i = 0; i < 16; ++i) acc[kb][i] = 0.f;
#pragma unroll 1
    for (int hb4 = 0; hb4 < 2; ++hb4) {
      bf16x8 qf[4][4];
      const f32x4 w4 = *(const f32x4*)(widx + qrow * 8 + hb4 * 4);
#pragma unroll
      for (int h = 0; h < 4; ++h)
#pragma unroll
        for (int s = 0; s < 4; ++s) qf[h][s] = *(const bf16x8*)(qidx + qrow * 512 + (hb4 * 4 + h) * 64 + 16 * s + 8 * hh);
#pragma unroll
      for (int h = 0; h < 4; ++h) {
        const float wh = w4[h];
#pragma unroll
        for (int kb = 0; kb < 2; ++kb) {
          f32x16 S;
#pragma unroll
          for (int i = 0; i < 16; ++i) S[i] = 0.f;
#pragma unroll
          for (int s = 0; s < 4; ++s) S = mfma32(Kf[kb][s], qf[h][s], S);
#pragma unroll
          for (int i = 0; i < 16; ++i) acc[kb][i] += wh * fmaxf(S[i], 0.f);
        }
      }
    }
    const bool rowok = qb == 0 ? (w == 0 && l31 < 16) : true;
    if (rowok) {
#pragma unroll
      for (int kb = 0; kb < 2; ++kb)
#pragma unroll
        for (int g = 0; g < 4; ++g) {
          const int kl = 32 * kb + 8 * g + 4 * hh;
          if (kl + 3 < valid) {
            f32x4 v = {acc[kb][4 * g], acc[kb][4 * g + 1], acc[kb][4 * g + 2], acc[kb][4 * g + 3]};
            *(f32x4*)(scores + qrow * SROW + start + kl) = v;
          }
        }
    }
  }
}

DI void topk_select(const float* scores, int* sel, char* smem) {
  const int tid = opaque_tid();
  const int lane = tid & 63, w = __builtin_amdgcn_readfirstlane(tid >> 6);
  unsigned* wsc = (unsigned*)(smem + w * 256);
  for (int row = blockIdx.x * 8 + w; row < M; row += gridDim.x * 8) {
    const int t = row % T;
    const int c = t < 16 ? 0 : 1 + ((t - 16) >> 6);
    const int nvis = 16 + 64 * c;
    if (nvis <= 256) continue;
    unsigned u[33];
    const float* sr = scores + (size_t)row * SROW;
#pragma unroll
    for (int j = 0; j < 33; ++j) {
      const int idx = lane + 64 * j;
      u[j] = __float_as_uint(sr[idx < nvis ? idx : nvis - 1]);
    }
#pragma unroll
    for (int j = 0; j < 33; ++j) {
      const int idx = lane + 64 * j;
      const unsigned bits = u[j];
      u[j] = idx < nvis ? ((bits & 0x80000000u) ? ~bits : (bits | 0x80000000u)) : 0u;
    }
    unsigned prefix = 0;
    for (int bit = 31; bit >= 20; --bit) {
      const unsigned cand = prefix | (1u << bit);
      int cnt = 0;
#pragma unroll
      for (int j = 0; j < 33; ++j) cnt += __builtin_popcountll(__ballot(u[j] >= cand));
      if (cnt >= 256) prefix = cand;
    }
    {
      const unsigned hi = prefix >> 20;
      const unsigned long long lm = (1ull << lane) - 1ull;
      int above = 0, nb = 0;
#pragma unroll
      for (int j = 0; j < 33; ++j) {
        above += __builtin_popcountll(__ballot((u[j] >> 20) > hi));
        const bool pb = (u[j] >> 20) == hi;
        const unsigned long long mb_ = __ballot(pb);
        const int pos = nb + __builtin_popcountll(mb_ & lm);
        if (pb && pos < 64) wsc[pos] = u[j];
        nb += __builtin_popcountll(mb_);
      }
      if (nb <= 64) {
        const int need_rank = 256 - above;
        asm volatile("s_waitcnt lgkmcnt(0)" ::: "memory");
        unsigned cv = wsc[lane];
        cv = lane < nb ? cv : 0u;
        for (int bit = 19; bit >= 0; --bit) {
          const unsigned cand = prefix | (1u << bit);
          if (__builtin_popcountll(__ballot(cv >= cand)) >= need_rank) prefix = cand;
        }
      } else {
        for (int bit = 19; bit >= 0; --bit) {
          const unsigned cand = prefix | (1u << bit);
          int cnt = 0;
#pragma unroll
          for (int j = 0; j < 33; ++j) cnt += __builtin_popcountll(__ballot(u[j] >= cand));
          if (cnt >= 256) prefix = cand;
        }
      }
    }
    int cgt = 0;
#pragma unroll
    for (int j = 0; j < 33; ++j) cgt += __builtin_popcountll(__ballot(u[j] > prefix));
    const int need = 256 - cgt;
    int base = 0, ebase = 0;
    int* so = sel + (size_t)row * 256;
    const unsigned long long lmask = (1ull << lane) - 1ull;
#pragma unroll
    for (int j = 0; j < 33; ++j) {
      const bool pg = u[j] > prefix;
      const unsigned long long mg = __ballot(pg);
      if (pg) so[base + __builtin_popcountll(mg & lmask)] = lane + 64 * j;
      base += __builtin_popcountll(mg);
      const bool pe = u[j] == prefix;
      const unsigned long long me = __ballot(pe);
      const int rk = ebase + __builtin_popcountll(me & lmask);
      if (pe && rk < need) so[cgt + rk] = lane + 64 * j;
      ebase += __builtin_popcountll(me);
    }
  }
}

DI void sparse_attn(const Params& p, u16* qabs, const float* ssq, const u16* ckv, const int* sel, char* smem) {
  constexpr int KS = 544;
  const int tid = opaque_tid(), lane = tid & 63, w = __builtin_amdgcn_readfirstlane(tid >> 6);
  const int g = lane >> 4, h = lane & 15, q4 = (lane & 15) >> 2, p4 = lane & 3;
  char* tl = smem + w * (32 * KS);
  float* s_relb = (float*)(smem + 8 * 32 * KS);
  float* s_gq = s_relb + 512;
  unsigned char* s_btab = (unsigned char*)(s_gq + 256);
  s_relb[tid] = p.relb[tid] * LOG2E;
  if (tid < 256) { s_gq[tid] = p.b_qn[tid]; s_btab[tid] = (unsigned char)t5_bucket(tid - 128); }
  __syncthreads();
  for (int row = blockIdx.x * 8 + w; row < M; row += gridDim.x * 8) {
    const int b = row / T, t = row % T;
    const int c = t < 16 ? 0 : 1 + ((t - 16) >> 6);
    const int nvis = 16 + 64 * c;
    const int nsel = nvis < 256 ? nvis : 256;
    const int ntile = (nsel + 31) >> 5;
    const bool use_sel = nvis > 256;
    int h2 = h;
    asm volatile("" : "+v"(h2));
    const float rsq = rsqrtf((ssq[(size_t)row * 32 + 2 * h2] + ssq[(size_t)row * 32 + 2 * h2 + 1]) * (1.f / 256.f) + 1e-6f) * (0.0625f * LOG2E);
    bf16x8 qf[8];
    u16* qrowp = qabs + (size_t)row * 4096 + h2 * 256;
#pragma unroll
    for (int s = 0; s < 8; ++s) {
      u32x4 raw = *(const u32x4*)(qrowp + 32 * s + 8 * g);
      f32x4 g0 = *(const f32x4*)(s_gq + 32 * s + 8 * g), g1 = *(const f32x4*)(s_gq + 32 * s + 8 * g + 4);
      qf[s] = mk8(pack2(bflo(raw[0]) * rsq * g0[0], bfhi(raw[0]) * rsq * g0[1]), pack2(bflo(raw[1]) * rsq * g0[2], bfhi(raw[1]) * rsq * g0[3]),
                  pack2(bflo(raw[2]) * rsq * g1[0], bfhi(raw[2]) * rsq * g1[1]), pack2(bflo(raw[3]) * rsq * g1[2], bfhi(raw[3]) * rsq * g1[3]));
    }
    f32x4 O[16];
#pragma unroll
    for (int rb = 0; rb < 16; ++rb) O[rb] = (f32x4){0.f, 0.f, 0.f, 0.f};
    float l = 0.f;
    int sel4[4];
#pragma unroll
    for (int j4 = 0; j4 < 4; ++j4) sel4[j4] = sel[(size_t)row * 256 + j4 * 64 + lane];
#pragma unroll
    for (int j4 = 0; j4 < 4; ++j4) {
      const int si = j4 * 64 + lane;
      sel4[j4] = si < nsel ? (use_sel ? sel4[j4] : si) : 0;
    }
    u32x4 G[8];
    int selv = shfl_i(sel4[0], lane & 31);
#pragma unroll
    for (int hf = 0; hf < 2; ++hf) {
#pragma unroll
      for (int it = 0; it < 8; ++it) {
        const int kl = 16 * hf + 2 * it + (lane >> 5);
        const int idx = shfl_i(selv, kl);
        G[it] = *(const u32x4*)(ckv + ((size_t)b * T + idx) * 256 + (lane & 31) * 8);
      }
#pragma unroll
      for (int it = 0; it < 8; ++it) *(u32x4*)(tl + (16 * hf + 2 * it + (lane >> 5)) * KS + (lane & 31) * 16) = G[it];
    }
    for (int tile = 0; tile < ntile; ++tile) {
      int selv_n = 0;
      if (tile + 1 < ntile) {
        const int tn_ = tile + 1;
        const int sj = (tn_ >> 1) == 0 ? sel4[0] : ((tn_ >> 1) == 1 ? sel4[1] : ((tn_ >> 1) == 2 ? sel4[2] : sel4[3]));
        selv_n = shfl_i(sj, (tn_ & 1) * 32 + (lane & 31));
#pragma unroll
        for (int it = 0; it < 6; ++it) {
          const int kl = 2 * it + (lane >> 5);
          const int idx = shfl_i(selv_n, kl);
          G[it] = *(const u32x4*)(ckv + ((size_t)b * T + idx) * 256 + (lane & 31) * 8);
        }
      }
      __builtin_amdgcn_sched_barrier(0);
      f32x4 S[2];
#pragma unroll
      for (int mb = 0; mb < 2; ++mb) {
        S[mb] = (f32x4){0.f, 0.f, 0.f, 0.f};
#pragma unroll
        for (int s = 0; s < 8; ++s) {
          bf16x8 a = *(const bf16x8*)(tl + (16 * mb + h) * KS + 64 * s + 16 * g);
          S[mb] = mfma16(a, qf[s], S[mb]);
        }
      }
#pragma unroll
      for (int mb = 0; mb < 2; ++mb)
#pragma unroll
        for (int i = 0; i < 4; ++i) {
          const int kl = 16 * mb + 4 * g + i;
          const int kp = shfl_i(selv, kl);
          const float okf = (tile * 32 + kl < nsel) ? 1.f : 0.f;
          const float pv = __builtin_amdgcn_exp2f(S[mb][i] + bias_lookup(s_relb, s_btab, kp - t, h)) * okf;
          l += pv;
          S[mb][i] = pv;
        }
      bf16x8 pf = mk8(pack2(S[0][0], S[0][1]), pack2(S[0][2], S[0][3]), pack2(S[1][0], S[1][1]), pack2(S[1][2], S[1][3]));
#pragma unroll
      for (int rb = 0; rb < 16; ++rb) {
        s16x4 lo = tr_read(tl + (4 * g + q4) * KS + 32 * rb + 8 * p4);
        s16x4 hi = tr_read(tl + (16 + 4 * g + q4) * KS + 32 * rb + 8 * p4);
        O[rb] = mfma16(cat8(lo, hi), pf, O[rb]);
      }
      __builtin_amdgcn_sched_barrier(0);
      if (tile + 1 < ntile) {
        asm volatile("s_waitcnt lgkmcnt(0)" ::: "memory");
#pragma unroll
        for (int it = 0; it < 6; ++it) *(u32x4*)(tl + (2 * it + (lane >> 5)) * KS + (lane & 31) * 16) = G[it];
        __builtin_amdgcn_sched_barrier(0);
#pragma unroll
        for (int hf = 0; hf < 2; ++hf) {
          u32x4 G2[5];
#pragma unroll
          for (int it = 0; it < 5; ++it) {
            const int kl = 12 + 10 * hf + 2 * it + (lane >> 5);
            const int idx = shfl_i(selv_n, kl);
            G2[it] = *(const u32x4*)(ckv + ((size_t)b * T + idx) * 256 + (lane & 31) * 8);
          }
#pragma unroll
          for (int it = 0; it < 5; ++it) *(u32x4*)(tl + (12 + 10 * hf + 2 * it + (lane >> 5)) * KS + (lane & 31) * 16) = G2[it];
          __builtin_amdgcn_sched_barrier(0);
        }
        selv = selv_n;
      }
    }
    l += shx(l, 16, lane);
    l += shx(l, 32, lane);
    const float inv = 1.f / l;
    int h3 = h;
    asm volatile("" : "+v"(h3));
    u16* qout = qabs + (size_t)row * 4096 + h3 * 256;
#pragma unroll
    for (int rb = 0; rb < 16; ++rb) {
      u32x2 ov = MK2(pack2(O[rb][0] * inv, O[rb][1] * inv), pack2(O[rb][2] * inv, O[rb][3] * inv));
      *(u32x2*)(qout + 16 * rb + 4 * g) = ov;
    }
  }
  __syncthreads();
}

DI void init_h(const Params& p) {
  float* h = (float*)(p.ws + OFF_H);
  u16* hb = (u16*)(p.ws + OFF_HB);
  const size_t n4 = (size_t)M * D / 4;
  for (size_t i = (size_t)blockIdx.x * NT + opaque_tid(); i < n4; i += (size_t)gridDim.x * NT) {
    const size_t e = i * 4;
    const int row = (int)(e / D), col = (int)(e % D);
    const int b = row / T, t = row % T;
    f32x4 v = t < 16 ? *(const f32x4*)(p.meta + (size_t)t * D + col) : *(const f32x4*)(p.x + ((size_t)b * 2048 + (t - 16)) * D + col);
    *(f32x4*)(h + e) = v;
    *(u32x2*)(hb + e) = MK2(pack2(v[0], v[1]), pack2(v[2], v[3]));
  }
}

DI void conv_layer(const Params& p, char* wsb, int layer, char* smem, int part, int rank, int nwork) {
  char* W = wsb + OFF_W;
  if (part & 2) conv_job(p.wo2 + (size_t)layer * DFF * D, D, DFF, D, CV_ID, nullptr, (u16*)(W + W_WO2), smem, rank, nwork);
  if (!(part & 1)) return;
  conv_job(p.wi1 + (size_t)layer * D * 2 * DFF, 2 * DFF, D, 2 * DFF, CV_FFN, p.ln1 + layer * D, (u16*)(W + W_WI1), smem, rank, nwork);
  conv_job(p.wo1 + (size_t)layer * DFF * D, D, DFF, D, CV_ID, nullptr, (u16*)(W + W_WO1), smem, rank, nwork);
  conv_job(p.wi2 + (size_t)layer * D * 2 * DFF, 2 * DFF, D, 2 * DFF, CV_FFN, p.ln2 + layer * D, (u16*)(W + W_WI2), smem, rank, nwork);
  conv_job(p.wout + (size_t)layer * D * D, D, D, D, CV_ID, nullptr, (u16*)(W + W_OUT), smem, rank, nwork);
  const int kind = layer % 3, j = layer / 3;
  const float* lnm = p.lnm + layer * D;
  if (kind == 0) {
    conv_job(p.a_win + (size_t)j * D * 3072, 3072, D, 3072, CV_ID, lnm, (u16*)(W + W_MIX), smem, rank, nwork);
  } else if (kind == 1) {
    conv_job(p.b_win, 584, D, 768, CV_PAD, lnm, (u16*)(W + W_MIX), smem, rank, nwork);
    conv_job(p.b_wuq, 4608, 256, 4608, CV_ID, p.b_lat, (u16*)(W + W_MIX + 1572864), smem, rank, nwork);
    conv_job(p.b_wuv, 64, 1024, 1024, CV_UVBD, nullptr, (u16*)(W + W_MIX + 3932160), smem, rank, nwork);
  } else {
    conv_job(p.c_win, 1280, D, 1280, CV_ID, lnm, (u16*)(W + W_MIX), smem, rank, nwork);
  }
}

enum { G_FFN1_WI = 0, G_FFN1_WO, G_FFN2_WI, G_FFN2_WO, G_A_IN, G_B_IN, G_B_QIDX, G_B_QABS, G_B_UV, G_C_IN, G_WOUT_AC, G_WOUT_B,
       ST_CONV = 32, ST_ATTN_A, ST_ATTN_C, ST_SCORES, ST_TOPK, ST_SPARSE };

DI int step_code(int kind, int st) {
  if (st == 0) return ST_CONV;
  if (st == 1) return G_FFN1_WI;
  if (st == 2) return G_FFN1_WO;
  const int nmix = kind == 1 ? 8 : 3;
  const int ms = st - 3;
  if (ms >= nmix) return ms == nmix ? G_FFN2_WI : G_FFN2_WO;
  if (kind == 0) return ms == 0 ? G_A_IN : (ms == 1 ? ST_ATTN_A : G_WOUT_AC);
  if (kind == 2) return ms == 0 ? G_C_IN : (ms == 1 ? ST_ATTN_C : G_WOUT_AC);
  switch (ms) {
    case 0: return G_B_IN;
    case 1: return G_B_QIDX;
    case 2: return ST_SCORES;
    case 3: return ST_TOPK;
    case 4: return G_B_QABS;
    case 5: return ST_SPARSE;
    case 6: return G_B_UV;
    default: return G_WOUT_B;
  }
}

DI GemmCfg make_cfg(const Params& p, char* wsb, int id, int layer) {
  char* W = wsb + OFF_W;
  char* AR = wsb + OFF_AR;
  const u16* hb = (const u16*)(wsb + OFF_HB);
  const int j = layer / 3;
  GemmCfg c;
  {
    const int z32 = (int)(wsb - p.ws);
    c.A = hb; c.lda = z32; c.a_koff_tn = z32; c.Bt = hb; c.K = z32; c.N = z32; c.epi = z32; c.use_rs = z32;
    c.o16 = (u16*)wsb; c.ldo = z32; c.gain = p.relb; c.nk_end = z32; c.f0 = (float*)wsb; c.o16b = (u16*)wsb; c.f1 = (float*)wsb;
  }
  switch (id) {
    case G_FFN1_WI: case G_FFN2_WI:
      c.A = hb; c.lda = D; c.Bt = (const u16*)(W + (id == G_FFN2_WI ? W_WI2 : W_WI1)); c.K = D; c.N = 2 * DFF; c.epi = EPI_SWIGLU; c.use_rs = 1;
      c.o16 = (u16*)(AR + AR_ACT);
      break;
    case G_FFN1_WO: case G_FFN2_WO:
      c.A = (const u16*)(AR + AR_ACT); c.lda = DFF; c.Bt = (const u16*)(W + (id == G_FFN2_WO ? W_WO2 : W_WO1)); c.K = DFF; c.N = D; c.epi = EPI_RESID;
      break;
    case G_A_IN:
      c.A = hb; c.lda = D; c.Bt = (const u16*)(W + W_MIX); c.K = D; c.N = 3072; c.epi = EPI_QKV; c.use_rs = 1;
      c.o16 = (u16*)(AR + AR_QKV); c.ldo = 3072; c.gain = p.a_qkn + j * 128; c.nk_end = 16;
      break;
    case G_C_IN:
      c.A = hb; c.lda = D; c.Bt = (const u16*)(W + W_MIX); c.K = D; c.N = 1280; c.epi = EPI_QKV; c.use_rs = 1;
      c.o16 = (u16*)(AR + AR_QKV); c.ldo = 1280; c.gain = p.c_qkn; c.nk_end = 9;
      break;
    case G_B_IN:
      c.A = hb; c.lda = D; c.Bt = (const u16*)(W + W_MIX); c.K = D; c.N = 768; c.epi = EPI_B_IN; c.use_rs = 1;
      c.o16 = (u16*)(AR + AR_CQ); c.f0 = (float*)(AR + AR_O_B); c.o16b = (u16*)(AR + AR_KIDX); c.f1 = (float*)(AR + AR_WIDX);
      break;
    case G_B_QIDX:
      c.A = (const u16*)(AR + AR_CQ); c.lda = 256; c.Bt = (const u16*)(W + W_MIX + 1572864) + (size_t)4096 * 256;
      c.K = 256; c.N = 512; c.epi = EPI_QIDX; c.use_rs = 1; c.o16 = (u16*)(AR + AR_QIDX);
      break;
    case G_B_QABS:
      c.A = (const u16*)(AR + AR_CQ); c.lda = 256; c.Bt = (const u16*)(W + W_MIX + 1572864);
      c.K = 256; c.N = 4096; c.epi = EPI_QABS; c.use_rs = 1; c.o16 = (u16*)(AR + AR_BIG); c.f0 = (float*)(AR + AR_SSQ);
      break;
    case G_B_UV:
      c.A = (const u16*)(AR + AR_BIG); c.lda = 4096; c.a_koff_tn = 1024;
      c.Bt = (const u16*)(W + W_MIX + 3932160); c.K = 1024; c.N = 1024; c.epi = EPI_PLAIN; c.use_rs = 0;
      c.o16 = (u16*)(AR + AR_O_B); c.ldo = D;
      break;
    case G_WOUT_AC: case G_WOUT_B:
      c.A = (const u16*)(AR + (id == G_WOUT_B ? AR_O_B : AR_O_AC)); c.lda = D;
      c.Bt = (const u16*)(W + W_OUT); c.K = D; c.N = D; c.epi = EPI_RESID;
      break;
  }
  return c;
}

#ifndef PROBE_DUP
#define PROBE_DUP(code) 0
#endif
__global__ void __launch_bounds__(NT, 2) mega(Params p) {
  cg::grid_group grid = cg::this_grid();
  __shared__ __attribute__((aligned(16))) char smem[SMEM_BYTES];
  __shared__ __attribute__((aligned(16))) unsigned xb_words[4];
  if (threadIdx.x < 4) xb_words[threadIdx.x] = 0u;
  __syncthreads();
  const XcdBarrier xb = xcd_barrier_post((unsigned*)(p.ws + OFF_BAR), (volatile LAS unsigned*)xb_words);
  init_h(p);
  for (int layer = 0; layer < 4; ++layer) {
    const int kind = layer % 3, j = layer / 3;
    const int nsteps = kind == 1 ? 13 : 8;
    for (int st = (layer == 0 ? 0 : 1); st < nsteps; ++st) {
      const int code = step_code(kind, st);
      size_t zoff = 0;
      asm volatile("" : "+s"(zoff));
      char* wsb = p.ws + zoff;
      char* AR = wsb + OFF_AR;
      for (int dup = 0; dup < ((PROBE_DUP(code)) ? 2 : 1); ++dup) {
      if (dup) xcd_barrier(xb);
      if (code < 32) {
        if (code == G_B_QIDX) kvnorm_pass((const float*)(AR + AR_O_B), p.b_lat + 256, (u16*)(AR + AR_CKV));
        const GemmCfg c = make_cfg(p, wsb, code, layer);
        gemm_run(c, smem, (float*)(wsb + OFF_H), (u16*)(wsb + OFF_HB), p.out, (code == G_FFN2_WO && layer == 3) ? 1 : 0);
      }
      {
        const int Gg = gridDim.x;
        const int Lb = ((Gg & 7) == 0) ? (int)(blockIdx.x & 7) * (Gg >> 3) + (int)(blockIdx.x >> 3) : (int)blockIdx.x;
        const int nslow = 0;
        int cl = -1, part = 0, rank = Lb - nslow, nw = Gg - nslow;
        if (code == ST_CONV) { cl = layer; part = 3; rank = (int)blockIdx.x; nw = Gg; }
        else if (code == G_FFN2_WO && layer < 3 && dup == 0) { cl = layer + 1; part = 1; }
        else if (code == G_FFN1_WO && layer > 0 && dup == 0) { cl = layer; part = 2; }
        if (cl >= 0) conv_layer(p, wsb, cl, smem, part, rank, nw);
      }
      if (code < 32 || code == ST_CONV) {
      } else if (code == ST_ATTN_A) {
        const float lam_init = 0.8f - 0.6f * expf(-0.3f * (float)layer);
        attn_dense<128, true>(p, (const u16*)(AR + AR_QKV), 3072, (u16*)(AR + AR_O_AC), p.a_lam + j * 256, p.a_sub + j * 128,
                              lam_init, nullptr, smem);
      } else if (code == ST_ATTN_C) {
        attn_dense<64, false>(p, (const u16*)(AR + AR_QKV), 1280, (u16*)(AR + AR_O_AC), nullptr, nullptr, 0.f, p.c_sink, smem);
      } else if (code == ST_SCORES) {
        idx_scores((const u16*)(AR + AR_KIDX), (const u16*)(AR + AR_QIDX), (const float*)(AR + AR_WIDX), (float*)(AR + AR_BIG));
      } else if (code == ST_TOPK) {
        topk_select((const float*)(AR + AR_BIG), (int*)(AR + AR_SEL), smem);
      } else {
        sparse_attn(p, (u16*)(AR + AR_BIG), (const float*)(AR + AR_SSQ), (const u16*)(AR + AR_CKV), (const int*)(AR + AR_SEL), smem);
      }
      }
      if (layer == 0 && st == 0) grid.sync();
      else xcd_barrier(xb);
    }
  }
}

extern "C" void kernel_launch(void* const* d_in, const int* in_sizes, int n_in, void* d_out, int out_size,
                              void* d_ws, size_t ws_size, hipStream_t stream) {
  static int grid_blocks = 0;
  if (!grid_blocks) {
    int dev = 0, cus = 0, per_cu = 0;
    hipGetDevice(&dev);
    hipDeviceGetAttribute(&cus, hipDeviceAttributeMultiprocessorCount, dev);
    hipOccupancyMaxActiveBlocksPerMultiprocessor(&per_cu, mega, NT, 0);
    if (per_cu > 1) per_cu = 1;
    if (per_cu < 1) per_cu = 1;
    grid_blocks = cus * per_cu;
  }
  if (ws_size < WS_NEED) { fprintf(stderr, "workspace too small: %zu < %zu\n", ws_size, (size_t)WS_NEED); return; }
  Params p{};
  const float* const* in = (const float* const*)d_in;
  p.x = in[0]; p.meta = in[1]; p.relb = in[2]; p.ln1 = in[3]; p.wi1 = in[4]; p.wo1 = in[5]; p.lnm = in[6]; p.wout = in[7];
  p.ln2 = in[8]; p.wi2 = in[9]; p.wo2 = in[10]; p.a_win = in[11]; p.a_qkn = in[12]; p.a_lam = in[13]; p.a_sub = in[14];
  p.b_win = in[15]; p.b_lat = in[16]; p.b_wuq = in[17]; p.b_qn = in[18]; p.b_wuv = in[19]; p.c_win = in[20]; p.c_qkn = in[21];
  p.c_sink = in[22];
  p.out = (float*)d_out; p.ws = (char*)d_ws;
  hipMemsetAsync((char*)d_ws + OFF_BAR, 0, 16384, stream);
  void* args[] = {&p};
  hipError_t e = hipLaunchCooperativeKernel((void*)mega, dim3(grid_blocks), dim3(NT), args, 0, stream);
  if (e != hipSuccess) fprintf(stderr, "cooperative launch failed: %s (grid %d)\n", hipGetErrorString(e), grid_blocks);
}
```

```cpp
#include <hip/hip_runtime.h>
#include <hip/hip_cooperative_groups.h>
#include <cstdio>
namespace cg = cooperative_groups;

#define DI __device__ __forceinline__
typedef unsigned short u16;
typedef __attribute__((ext_vector_type(8))) short bf16x8;
typedef __attribute__((ext_vector_type(4))) short s16x4;
typedef __attribute__((ext_vector_type(16))) float f32x16;
typedef __attribute__((ext_vector_type(4))) float f32x4;
typedef __attribute__((ext_vector_type(2))) float f32x2;
typedef __attribute__((ext_vector_type(2))) __bf16 bf16x2;
typedef __attribute__((ext_vector_type(4))) unsigned u32x4;
typedef __attribute__((ext_vector_type(2))) unsigned u32x2;

constexpr int BATCH = 8, T = 2064, D = 1024, M = BATCH * T, DFF = 2816;
constexpr int SROW = 2080;

constexpr size_t OFF_H = 0;
constexpr size_t OFF_HB = OFF_H + (size_t)M * D * 4;
constexpr size_t OFF_W = OFF_HB + (size_t)M * D * 2;
constexpr size_t W_WI1 = 0, W_WO1 = 11534336, W_WI2 = 17301504, W_WO2 = 28835840, W_OUT = 34603008, W_MIX = 36700160;
constexpr size_t W_TOTAL = 42991616;
constexpr size_t OFF_AR = OFF_W + W_TOTAL;
constexpr size_t AR_ACT = 0;
constexpr size_t AR_QKV = 0;
constexpr size_t AR_O_AC = 101449728;
constexpr size_t AR_BIG = 0;
constexpr size_t AR_O_B = 137379840;
constexpr size_t AR_CQ = 171196416;
constexpr size_t AR_CKV = 179650560;
constexpr size_t AR_KIDX = 188104704;
constexpr size_t AR_WIDX = 190218240;
constexpr size_t AR_QIDX = 190746624;
constexpr size_t AR_SEL = 207654912;
constexpr size_t AR_SSQ = 224563200;
constexpr size_t OFF_BAR = OFF_AR + 226676736;
constexpr size_t WS_NEED = OFF_BAR + 16384;

constexpr int NT = 512;
constexpr int SMEM_BYTES = 4 * 256 * 144 + 1024;

struct Params {
  const float *x, *meta, *relb, *ln1, *wi1, *wo1, *lnm, *wout, *ln2, *wi2, *wo2;
  const float *a_win, *a_qkn, *a_lam, *a_sub, *b_win, *b_lat, *b_wuq, *b_qn, *b_wuv, *c_win, *c_qkn, *c_sink;
  float* out;
  char* ws;
};

#define MK4(a, b, c, d) ((u32x4){(a), (b), (c), (d)})
#define MK2(a, b) ((u32x2){(a), (b)})
DI unsigned pack2(float a, float b) {
  f32x2 v = {a, b};
  bf16x2 r = __builtin_convertvector(v, bf16x2);
  return __builtin_bit_cast(unsigned, r);
}
DI float dot2sq(unsigned v, float c) { bf16x2 a = __builtin_bit_cast(bf16x2, v); return __builtin_amdgcn_fdot2_f32_bf16(a, a, c, false); }
DI float bflo(unsigned v) { return __uint_as_float(v << 16); }
DI float bfhi(unsigned v) { return __uint_as_float(v & 0xffff0000u); }
DI int opaque_tid() { int t = threadIdx.x; asm volatile("" : "+v"(t)); return t; }
DI float shx(float v, int mask, int lane) { return __int_as_float(__builtin_amdgcn_ds_bpermute((lane ^ mask) << 2, __float_as_int(v))); }
DI int shfl_i(int v, int src) { return __builtin_amdgcn_ds_bpermute(src << 2, v); }
DI void lds_barrier() { asm volatile("s_waitcnt lgkmcnt(0)\n\ts_barrier" ::: "memory"); }
DI int crow(int i, int hh) { return (i & 3) + 8 * (i >> 2) + 4 * hh; }
DI f32x16 mfma32(bf16x8 a, bf16x8 b, f32x16 c) { return __builtin_amdgcn_mfma_f32_32x32x16_bf16(a, b, c, 0, 0, 0); }
DI f32x4 mfma16(bf16x8 a, bf16x8 b, f32x4 c) { return __builtin_amdgcn_mfma_f32_16x16x32_bf16(a, b, c, 0, 0, 0); }
DI s16x4 tr_read(const char* p) {
  return __builtin_amdgcn_ds_read_tr16_b64_v4i16((s16x4 __attribute__((address_space(3)))*)(unsigned)(size_t)p);
}
DI bf16x8 cat8(s16x4 lo, s16x4 hi) { return __builtin_shufflevector(lo, hi, 0, 1, 2, 3, 4, 5, 6, 7); }
DI bf16x8 mk8(unsigned a, unsigned b, unsigned c, unsigned d) {
  u32x4 u = MK4(a, b, c, d);
  return __builtin_bit_cast(bf16x8, u);
}
DI int t5_bucket(int rel) {
  int n = rel < 0 ? -rel : rel;
  int b = (n < 8 ? n : 8) + (n >= 12) + (n >= 16) + (n >= 23) + (n >= 32) + (n >= 46) + (n >= 64) + (n >= 91);
  return b + (rel > 0 ? 16 : 0);
}
DI float bias_lookup(const float* s_relb, const unsigned char* btab, int rel, int head) {
  const int idx = (rel < -128 ? -128 : (rel > 127 ? 127 : rel)) + 128;
  return s_relb[(int)btab[idx] * 16 + head];
}


#define XB_TMO      128
#define XB_XCNT(j)  (256  + 64 * (j))
#define XB_XSUB(j)  (1280 + 64 * (j))
#define XB_XGEN(j)  (2304 + 64 * (j))
#define XB_TOP      3328
#define XB_TOPGEN   3392
#define XCD_BAR_WORDS 3456
#define XB_SPIN_CAP (1u << 22)
#define LAS __attribute__((address_space(3)))
DI unsigned xb_ld(unsigned* p) { return __hip_atomic_load(p, __ATOMIC_RELAXED, __HIP_MEMORY_SCOPE_AGENT); }
DI unsigned xb_add(unsigned* p, unsigned v) { return __hip_atomic_fetch_add(p, v, __ATOMIC_RELAXED, __HIP_MEMORY_SCOPE_AGENT); }
DI unsigned xb_xcc_id() { return (unsigned)__builtin_amdgcn_s_getreg((3 << 11) | 20) & 0xFu; }
#define XB_SPIN(cond, bar) do { unsigned _sp = 0; while (cond) { __builtin_amdgcn_s_sleep(1); \
    if ((++_sp & 255u) == 0u) { if (xb_ld(&(bar)[XB_TMO])) break; if (_sp > XB_SPIN_CAP) { atomicAdd(&(bar)[XB_TMO], 1u); break; } } } } while (0)
struct XcdBarrier { unsigned* bar; unsigned x; volatile LAS unsigned* st; };
DI XcdBarrier xcd_barrier_post(unsigned* bar, volatile LAS unsigned* st) {
  XcdBarrier b; b.bar = bar; b.x = xb_xcc_id(); b.st = st;
  if (threadIdx.x == 0) (void)xb_add(&bar[XB_XCNT(b.x)], 1u);
  return b;
}
DI void xcd_barrier_complete(unsigned* bar, unsigned x, unsigned& nloc, unsigned& nx) {
  const unsigned G = gridDim.x * gridDim.y * gridDim.z;
  unsigned sum, cnt, mine, sp = 0u;
  for (;;) {
    sum = 0u; cnt = 0u; mine = 0u;
#pragma unroll
    for (unsigned j = 0; j < 16; ++j) { const unsigned c = xb_ld(&bar[XB_XCNT(j)]); sum += c; cnt += (c > 0u) ? 1u : 0u; mine = (j == x) ? c : mine; }
    if (sum == G) break;
    __builtin_amdgcn_s_sleep(1);
    if ((++sp & 255u) == 0u) { if (xb_ld(&bar[XB_TMO])) break; if (sp > XB_SPIN_CAP) { atomicAdd(&bar[XB_TMO], 1u); break; } }
  }
  nloc = mine > 0u ? mine : 1u; nx = cnt > 0u ? cnt : 1u;
}
DI void xcd_barrier(const XcdBarrier& b) {
  asm volatile("s_waitcnt vmcnt(0)" ::: "memory");
  __syncthreads();
  if (threadIdx.x == 0) {
    unsigned* bar = b.bar;
    __builtin_amdgcn_s_waitcnt(0);
    unsigned nloc = b.st[0], nx = b.st[1];
    if (nloc == 0u) { xcd_barrier_complete(bar, b.x, nloc, nx); b.st[0] = nloc; b.st[1] = nx; }
    const unsigned old = xb_add(&bar[XB_XSUB(b.x)], 1u);
    const unsigned gen = old / nloc;
    if (old + 1u == (gen + 1u) * nloc) {
      __builtin_amdgcn_fence(__ATOMIC_RELEASE, "agent");
      asm volatile("s_waitcnt vmcnt(0)" ::: "memory");
      const unsigned og = xb_add(&bar[XB_TOP], 1u);
      const unsigned tg = og / nx;
      if (og + 1u == (tg + 1u) * nx) xb_add(&bar[XB_TOPGEN], 1u);
      else XB_SPIN(xb_ld(&bar[XB_TOPGEN]) == tg, bar);
      __builtin_amdgcn_fence(__ATOMIC_ACQUIRE, "agent");
      xb_add(&bar[XB_XGEN(b.x)], 1u);
      asm volatile("s_waitcnt vmcnt(0)" ::: "memory");
    } else {
      XB_SPIN(xb_ld(&bar[XB_XGEN(b.x)]) == gen, bar);
      __builtin_amdgcn_fence(__ATOMIC_ACQUIRE, "agent");
      asm volatile("s_waitcnt vmcnt(0)" ::: "memory");
    }
  }
  __syncthreads();
}

enum { CV_ID = 0, CV_PAD = 1, CV_FFN = 2, CV_UVBD = 3 };
DI float conv_src(const float* src, int ld, int kind, int k, int n) {
  if (kind == CV_ID) return src[(size_t)k * ld + n];
  if (kind == CV_PAD) return n < ld ? src[(size_t)k * ld + n] : 0.f;
  if (kind == CV_FFN) {
    int tile = n >> 7, j = n & 127;
    int col = j < 64 ? tile * 64 + j : DFF + tile * 64 + (j - 64);
    return src[(size_t)k * ld + col];
  }
  int h = n >> 6, d = n & 63;
  return ((k >> 8) == (h & 3)) ? src[((size_t)h * 256 + (k & 255)) * 64 + d] : 0.f;
}
DI void conv_job(const float* src, int ld, int K, int N, int kind, const float* gain, u16* dst, char* smem, int rank, int nwork) {
  float* lds = (float*)smem;
  const int tid = opaque_tid();
  const int tk_n = K >> 7, tn_n = N >> 6;
  if (rank < 0) return;
  for (int tile = rank; tile < tk_n * tn_n; tile += nwork) {
    const int tk = tile % tk_n, tn = tile / tk_n;
    const int k0 = tk * 128, n0 = tn * 64;
    const int nn = tid & 63;
    float cv[16];
#pragma unroll
    for (int i = 0; i < 16; ++i) cv[i] = conv_src(src, ld, kind, k0 + (tid >> 6) + 8 * i, n0 + nn);
    if (gain) {
      float gv[16];
#pragma unroll
      for (int i = 0; i < 16; ++i) gv[i] = gain[k0 + (tid >> 6) + 8 * i];
#pragma unroll
      for (int i = 0; i < 16; ++i) cv[i] *= gv[i];
    }
#pragma unroll
    for (int i = 0; i < 16; ++i) lds[nn * 129 + (tid >> 6) + 8 * i] = cv[i];
    __syncthreads();
    {
      const int n2 = tid >> 3, ks = (tid & 7) * 16;
      const float* r = lds + n2 * 129 + ks;
      u32x4 o0 = MK4(pack2(r[0], r[1]), pack2(r[2], r[3]), pack2(r[4], r[5]), pack2(r[6], r[7]));
      u32x4 o1 = MK4(pack2(r[8], r[9]), pack2(r[10], r[11]), pack2(r[12], r[13]), pack2(r[14], r[15]));
      u32x4* d4 = (u32x4*)(dst + (size_t)(n0 + n2) * K + k0 + ks);
      d4[0] = o0; d4[1] = o1;
    }
    __syncthreads();
  }
}

enum { EPI_SWIGLU = 0, EPI_RESID, EPI_QKV, EPI_B_IN, EPI_QIDX, EPI_QABS, EPI_PLAIN };
struct GemmCfg {
  const u16* A; int lda; int a_koff_tn; const u16* Bt; int K; int N; int epi; int use_rs;
  u16* o16; int ldo;
  const float* gain; int nk_end;
  float* f0; u16* o16b; float* f1;
};

DI void epi_slab(const GemmCfg c, const f32x16 (&acc)[4], float* sW, const float* rss, const size_t row0, const int g, const int lane,
                 float* const g_h, u16* const g_hb, float* const g_out, const int final_out) {
  int ln_ = lane;
  asm volatile("" : "+v"(ln_));
  const int l31 = ln_ & 31, hh = ln_ >> 5;
#pragma unroll
  for (int nb = 0; nb < 4; ++nb)
#pragma unroll
    for (int i = 0; i < 16; ++i) sW[crow(i, hh) * 132 + nb * 32 + l31] = acc[nb][i];
  asm volatile("s_waitcnt lgkmcnt(0)" ::: "memory");
  const int K = c.K;
  const float invK = 1.0f / (float)K;
  if (c.epi == EPI_SWIGLU) {
    const int c4 = (ln_ & 15) * 4;
#pragma unroll 2
    for (int it = 0; it < 8; ++it) {
      const int r = (ln_ >> 4) + 4 * it;
      const float rs = rsqrtf(rss[r] * invK + 1e-6f);
      f32x4 a = *(const f32x4*)(sW + r * 132 + c4);
      f32x4 b = *(const f32x4*)(sW + r * 132 + 64 + c4);
      float y[4];
#pragma unroll
      for (int e = 0; e < 4; ++e) { float av = a[e] * rs, bv = b[e] * rs; y[e] = av * __builtin_amdgcn_rcpf(1.f + __expf(-av)) * bv; }
      *(u32x2*)(c.o16 + (row0 + r) * DFF + g * 64 + c4) = MK2(pack2(y[0], y[1]), pack2(y[2], y[3]));
    }
  } else if (c.epi == EPI_RESID) {
    const int c4 = l31 * 4;
    const int col = g * 128 + c4;
    const float sc = (K == DFF ? 0.5f : 1.f);
#pragma unroll
    for (int hb_ = 0; hb_ < 2; ++hb_) {
      f32x4 hv[8];
#pragma unroll
      for (int i8 = 0; i8 < 8; ++i8) hv[i8] = *(const f32x4*)(g_h + (row0 + hh + 2 * (hb_ * 8 + i8)) * D + col);
#pragma unroll
      for (int i8 = 0; i8 < 8; ++i8) {
        const int r = hh + 2 * (hb_ * 8 + i8);
        const size_t row = row0 + r;
        f32x4 v = *(const f32x4*)(sW + r * 132 + c4);
        f32x4 o = hv[i8] + v * sc;
        *(f32x4*)(g_h + row * D + col) = o;
        *(u32x2*)(g_hb + row * D + col) = MK2(pack2(o[0], o[1]), pack2(o[2], o[3]));
        if (final_out) {
          const int b = (int)(row / T), t = (int)(row % T);
          if (t >= 16) *(f32x4*)(g_out + ((size_t)b * 2048 + (t - 16)) * D + col) = o;
        }
      }
    }
  } else {
    const int c4 = l31 * 4;
    const int col = g * 128 + c4;
#pragma unroll 2
    for (int it = 0; it < 16; ++it) {
      const int r = hh + 2 * it;
      const size_t row = row0 + r;
      f32x4 v = *(const f32x4*)(sW + r * 132 + c4);
      const float rs = c.use_rs ? rsqrtf(rss[r] * invK + 1e-6f) : 1.f;
      if (c.epi == EPI_QKV) {
        f32x4 x = v * rs;
        float s = x[0] * x[0] + x[1] * x[1] + x[2] * x[2] + x[3] * x[3];
        s += shx(s, 1, ln_); s += shx(s, 2, ln_); s += shx(s, 4, ln_); s += shx(s, 8, ln_);
        if (g < c.nk_end) {
          const float r2 = rsqrtf(s * (1.f / 64.f) + 1e-6f) * (g < 8 ? 0.125f : 1.f);
          f32x4 gn = *(const f32x4*)(c.gain + (g < 8 ? 0 : 64) + (c4 & 63));
          x = x * gn * r2;
        }
        *(u32x2*)(c.o16 + row * c.ldo + col) = MK2(pack2(x[0], x[1]), pack2(x[2], x[3]));
      } else if (c.epi == EPI_B_IN) {
        f32x4 x = v * rs;
        float s = x[0] * x[0] + x[1] * x[1] + x[2] * x[2] + x[3] * x[3];
        s += shx(s, 1, ln_); s += shx(s, 2, ln_); s += shx(s, 4, ln_); s += shx(s, 8, ln_);
        if (g < 2) {
          *(u32x2*)(c.o16 + row * 256 + col) = MK2(pack2(x[0], x[1]), pack2(x[2], x[3]));
        } else if (g < 4) {
          *(f32x4*)(c.f0 + row * 256 + (col - 256)) = x;
        } else if (g == 4 && c4 < 64) {
          const float r2 = rsqrtf(s * (1.f / 64.f) + 1e-6f);
          x = x * r2;
          *(u32x2*)(c.o16b + row * 64 + c4) = MK2(pack2(x[0], x[1]), pack2(x[2], x[3]));
        } else if (g == 4 && c4 < 72) {
          *(f32x4*)(c.f1 + row * 8 + (c4 - 64)) = x * 0.35355339059327373f;
        }
      } else if (c.epi == EPI_QIDX) {
        f32x4 x = v * (rs * 0.125f);
        *(u32x2*)(c.o16 + row * 512 + col) = MK2(pack2(x[0], x[1]), pack2(x[2], x[3]));
      } else if (c.epi == EPI_QABS) {
        f32x4 x = v * rs;
        float s = x[0] * x[0] + x[1] * x[1] + x[2] * x[2] + x[3] * x[3];
        s += shx(s, 1, ln_); s += shx(s, 2, ln_); s += shx(s, 4, ln_); s += shx(s, 8, ln_); s += shx(s, 16, ln_);
        if (l31 == 0) c.f0[row * 32 + g] = s;
        *(u32x2*)(c.o16 + row * 4096 + col) = MK2(pack2(x[0], x[1]), pack2(x[2], x[3]));
      } else {
        *(u32x2*)(c.o16 + row * c.ldo + col) = MK2(pack2(v[0], v[1]), pack2(v[2], v[3]));
      }
    }
  }
  asm volatile("s_waitcnt lgkmcnt(0)" ::: "memory");
}

constexpr int GTS = 256 * 144;
DI void gemm_run(const GemmCfg c, char* smem, float* const g_h, u16* const g_hb, float* const g_out, const int final_out) {
  const int tid = opaque_tid(), lane = tid & 63, w = __builtin_amdgcn_readfirstlane(tid >> 6), wm = w >> 1, wn = w & 1;
  const int l31 = lane & 31, hh = lane >> 5;
  float* s_rowss = (float*)(smem + 4 * GTS);
  float* sW = (float*)(smem + w * (32 * 132 * 4));
  const int tilesN = c.N >> 8;
  const int K = c.K, nk = K >> 6;
  const int G = gridDim.x;
  const bool tail16 = (tilesN == 4) && (G == 256) && (c.epi == EPI_RESID || c.epi == EPI_PLAIN);
  const int ntiles = (tail16 ? 64 : 65) * tilesN;
  const int lrow = tid >> 3, lch = tid & 7;
  const int Lb = ((G & 7) == 0) ? (int)(blockIdx.x & 7) * (G >> 3) + (int)(blockIdx.x >> 3) : (int)blockIdx.x;
  const int srow = 8 * tilesN;
  for (int slot = Lb; slot < ntiles; slot += G) {
    const int sr = slot / srow, idx = slot - sr * srow;
    const int tm = sr < 8 ? sr * 8 + (idx & 7) : 64;
    const int tn = sr < 8 ? (idx >> 3) : idx;
    const u16* Ag = c.A + (size_t)(tm * 256 + lrow) * c.lda + tn * c.a_koff_tn + lch * 8;
    const u16* Bg = c.Bt + (size_t)(tn * 256 + lrow) * K + lch * 8;
    const size_t astep = (size_t)64 * c.lda, bstep = (size_t)64 * K;
    f32x16 acc[2][4];
#pragma unroll
    for (int a = 0; a < 2; ++a)
#pragma unroll
      for (int b = 0; b < 4; ++b)
#pragma unroll
        for (int i = 0; i < 16; ++i) acc[a][b][i] = 0.f;
    float ss[4] = {0.f, 0.f, 0.f, 0.f};
    u32x4 ra0[4], rb0[4];
#define G_LOAD(RA, RB, KT) { size_t as_ = astep, bs_ = bstep; asm volatile("" : "+s"(as_), "+s"(bs_)); \
      _Pragma("unroll") for (int i = 0; i < 4; ++i) { RA[i] = *(const u32x4*)(Ag + i * as_ + (KT) * 64); RB[i] = *(const u32x4*)(Bg + i * bs_ + (KT) * 64); } }
#define G_STORE(RA, RB, BUF) { _Pragma("unroll") for (int i = 0; i < 4; ++i) { \
      *(u32x4*)(smem + (BUF) * GTS + (lrow + 64 * i) * 144 + lch * 16) = RA[i]; \
      *(u32x4*)(smem + 2 * GTS + (BUF) * GTS + (lrow + 64 * i) * 144 + lch * 16) = RB[i]; } \
      _Pragma("unroll") for (int i = 0; i < 4; ++i) \
        ss[i] = dot2sq(RA[i][3], dot2sq(RA[i][2], dot2sq(RA[i][1], dot2sq(RA[i][0], ss[i])))); }
#define K_FRAG(S, FA, FB) { \
        _Pragma("unroll") for (int q_ = 0; q_ < 2; ++q_) FA[q_] = *(const bf16x8*)(sAc + (wm * 64 + q_ * 32 + l31) * 144 + (2 * (S) + hh) * 16); \
        _Pragma("unroll") for (int q_ = 0; q_ < 4; ++q_) FB[q_] = *(const bf16x8*)(sBc + (wn * 128 + q_ * 32 + l31) * 144 + (2 * (S) + hh) * 16); }
#define K_STEP(CUR, NXT, KTL, DOSTORE, DOLOAD) { \
      const char* sAc = smem + (CUR) * GTS; const char* sBc = smem + 2 * GTS + (CUR) * GTS; \
      size_t as_ = astep, bs_ = bstep; asm volatile("" : "+s"(as_), "+s"(bs_)); \
      _Pragma("unroll") for (int s = 0; s < 4; ++s) { \
        bf16x8 fa[1][2], fb[1][4]; \
        K_FRAG(s, fa[0], fb[0]); \
        if (DOSTORE) { \
          *(u32x4*)(smem + (NXT) * GTS + (lrow + 64 * s) * 144 + lch * 16) = ra0[s]; \
          *(u32x4*)(smem + 2 * GTS + (NXT) * GTS + (lrow + 64 * s) * 144 + lch * 16) = rb0[s]; \
          ss[s] = dot2sq(ra0[s][3], dot2sq(ra0[s][2], dot2sq(ra0[s][1], dot2sq(ra0[s][0], ss[s])))); } \
        if (DOLOAD) { ra0[s] = *(const u32x4*)(Ag + s * as_ + (KTL) * 64); rb0[s] = *(const u32x4*)(Bg + s * bs_ + (KTL) * 64); } \
        _Pragma("unroll") for (int mb = 0; mb < 2; ++mb) \
          _Pragma("unroll") for (int nb = 0; nb < 4; ++nb) acc[mb][nb] = mfma32(fa[0][mb], fb[0][nb], acc[mb][nb]); \
        __builtin_amdgcn_sched_group_barrier(0x100, 6, 0); \
        __builtin_amdgcn_sched_group_barrier(0x008, 1, 0); __builtin_amdgcn_sched_group_barrier(0x200, 1, 0); \
        __builtin_amdgcn_sched_group_barrier(0x008, 1, 0); __builtin_amdgcn_sched_group_barrier(0x200, 1, 0); \
        __builtin_amdgcn_sched_group_barrier(0x008, 1, 0); __builtin_amdgcn_sched_group_barrier(0x002, 4, 0); \
        __builtin_amdgcn_sched_group_barrier(0x008, 1, 0); __builtin_amdgcn_sched_group_barrier(0x020, 1, 0); \
        __builtin_amdgcn_sched_group_barrier(0x008, 1, 0); __builtin_amdgcn_sched_group_barrier(0x020, 1, 0); \
        __builtin_amdgcn_sched_group_barrier(0x008, 3, 0); \
        __builtin_amdgcn_sched_barrier(0); } }
    G_LOAD(ra0, rb0, 0);
    __syncthreads();
    G_STORE(ra0, rb0, 0);
    G_LOAD(ra0, rb0, 1);
    lds_barrier();
    int kt = 0;
    for (; kt + 3 < nk; kt += 2) {
      K_STEP(0, 1, kt + 2, true, true);
      lds_barrier();
      K_STEP(1, 0, kt + 3, true, true);
      lds_barrier();
    }
    K_STEP(0, 1, 0, true, false);
    lds_barrier();
    K_STEP(1, 0, 0, false, false);
    lds_barrier();
#undef K_STEP
#undef K_FRAG
#undef G_LOAD
#undef G_STORE
    if (c.use_rs) {
#pragma unroll
      for (int i = 0; i < 4; ++i) {
        float s_ = ss[i];
        s_ += shx(s_, 1, lane); s_ += shx(s_, 2, lane); s_ += shx(s_, 4, lane);
        if (lch == 0) s_rowss[lrow + 64 * i] = s_;
      }
    }
    __syncthreads();
#pragma unroll
    for (int mb = 0; mb < 2; ++mb) {
      const size_t row0 = (size_t)tm * 256 + wm * 64 + mb * 32;
      if (row0 < (size_t)M) epi_slab(c, acc[mb], sW, s_rowss + wm * 64 + mb * 32, row0, tn * 2 + wn, lane, g_h, g_hb, g_out, final_out);
    }
  }
  __syncthreads();
  if (tail16) {
    float* sP = (float*)smem;
    const int l15 = lane & 15, kq = lane >> 4;
    const int Kw = K >> 3;
    for (int t = (int)blockIdx.x; t < 512; t += G) {
      const int rg = t & 7, cg = t >> 3;
      const u16* Ap = c.A + (size_t)(16384 + rg * 16 + l15) * c.lda + (cg >> 4) * c.a_koff_tn + w * Kw + kq * 8;
      const u16* Bp = c.Bt + (size_t)(cg * 16 + l15) * K + w * Kw + kq * 8;
      f32x4 a4 = {0.f, 0.f, 0.f, 0.f};
#pragma unroll 4
      for (int k = 0; k < Kw; k += 32) {
        bf16x8 av = *(const bf16x8*)(Ap + k);
        bf16x8 bv = *(const bf16x8*)(Bp + k);
        a4 = mfma16(av, bv, a4);
      }
#pragma unroll
      for (int i = 0; i < 4; ++i) sP[w * 256 + (kq * 4 + i) * 16 + l15] = a4[i];
      __syncthreads();
      if (tid < 256) {
        const float v = ((sP[tid] + sP[256 + tid]) + (sP[512 + tid] + sP[768 + tid])) + ((sP[1024 + tid] + sP[1280 + tid]) + (sP[1536 + tid] + sP[1792 + tid]));
        const size_t row = 16384 + rg * 16 + (tid >> 4);
        const int col = cg * 16 + (tid & 15);
        if (c.epi == EPI_RESID) {
          const float o = g_h[row * D + col] + v * (K == DFF ? 0.5f : 1.f);
          g_h[row * D + col] = o;
          g_hb[row * D + col] = (u16)(pack2(o, o) & 0xffffu);
          if (final_out) {
            const int b = (int)(row / T), t2 = (int)(row % T);
            if (t2 >= 16) g_out[((size_t)b * 2048 + (t2 - 16)) * D + col] = o;
          }
        } else {
          c.o16[row * c.ldo + col] = (u16)(pack2(v, v) & 0xffffu);
        }
      }
      __syncthreads();
    }
  }
  __syncthreads();
}

template <int VD, bool DIFF>
DI void attn_dense(const Params& p, const u16* qkv, int ld, u16* o, const float* lam4, const float* subln,
                           float lam_init, const float* sinks, char* smem) {
  constexpr int VS = VD * 2 + 64;
  constexpr int NDB = VD / 32;
  constexpr int NVL = VD / 64;
  constexpr int TB = 9216 + 64 * VS;
  float* s_relb = (float*)(smem + 2 * TB);
  const int tid = opaque_tid(), lane = tid & 63, w = __builtin_amdgcn_readfirstlane(tid >> 6);
  unsigned* s_stash = (unsigned*)(smem + 2 * TB + 2048) + w * 2048 + lane;
  const int l31 = lane & 31, hh = lane >> 5;
  const int q4 = (lane & 15) >> 2, p4 = lane & 3, blk = (lane >> 4) & 1;
  unsigned char* s_btab = (unsigned char*)(smem + 2 * TB + 2048 + 65536);
  if (tid < 512) s_relb[tid] = p.relb[tid];
  if (tid < 256) s_btab[tid] = (unsigned char)t5_bucket(tid - 128);
  float* s_sub = (float*)(smem + 2 * TB + 2048 + 65536 + 256);
  if (DIFF && tid < 128) s_sub[tid] = subln[tid];
  float lam_full = 0.f;
  if (DIFF) {
    float v1 = lam4[lane] * lam4[64 + lane], v2 = lam4[128 + lane] * lam4[192 + lane];
#pragma unroll
    for (int o_ = 32; o_ >= 1; o_ >>= 1) { v1 += shx(v1, o_, lane); v2 += shx(v2, o_, lane); }
    lam_full = __expf(v1) - __expf(v2) + lam_init;
  }
  __syncthreads();
  constexpr int NH = DIFF ? 8 : 16;
  const int nitems = DIFF ? (256 + 64) : (BATCH * NH * 9);
  for (int item = blockIdx.x; item < nitems; item += gridDim.x) {
    int b, hd, qb0, nrep;
    if (DIFF) {
      if (item < 256) { const int pi = item >> 6; b = (item >> 3) & 7; hd = item & 7; qb0 = 8 - pi; nrep = 2; }
      else { const int r = item - 256; b = r >> 3; hd = r & 7; qb0 = 0; nrep = 1; }
    } else {
      qb0 = 8 - item / (BATCH * NH); const int r = item % (BATCH * NH); b = r / NH; hd = r % NH; nrep = 1;
    }
    for (int rep = 0; rep < nrep; ++rep) {
      const int qb = rep == 0 ? qb0 : 9 - qb0;
      const int qbase = qb == 0 ? 32 * w : 16 + 256 * (qb - 1) + 32 * w;
      const int cq_w = qb == 0 ? 0 : 4 * (qb - 1) + 1 + (w >> 1);
      const int cq_max = qb == 0 ? 0 : 4 * qb;
      const int jlo_blk = DIFF ? 1 : (qb == 0 ? 1 : (4 * qb - 5 > 1 ? 4 * qb - 5 : 1));
      const int jlo_w = DIFF ? 1 : (cq_w - 2 > 1 ? cq_w - 2 : 1);
      const int ntl = 1 + (cq_max >= jlo_blk ? cq_max - jlo_blk + 1 : 0);
      const size_t qrow = (size_t)b * T + qbase + l31;
      const int vcol = DIFF ? 2048 + hd * 128 : 1152 + (hd >> 3) * 64;
      for (int mm = 0; mm < (DIFF ? 2 : 1); ++mm) {
        const int qcol = DIFF ? hd * 128 + mm * 64 : hd * 64;
        const int kcol = DIFF ? 1024 + hd * 128 + mm * 64 : 1024 + (hd >> 3) * 64;
        const int bh = DIFF ? mm * 8 + hd : hd;
        bf16x8 qf[4];
#pragma unroll
        for (int s = 0; s < 4; ++s) qf[s] = *(const bf16x8*)(qkv + qrow * ld + qcol + 16 * s + 8 * hh);
        f32x16 O[NDB];
#pragma unroll
        for (int d_ = 0; d_ < NDB; ++d_)
#pragma unroll
          for (int i = 0; i < 16; ++i) O[d_][i] = 0.f;
        float l = 0.f;
        const float bfar = s_relb[15 * 16 + bh];
        const int lkey = tid >> 3;
        u32x4 rk, rv[NVL];
        {
          const size_t krow = (size_t)b * T + lkey;
          rk = *(const u32x4*)(qkv + krow * ld + kcol + (tid & 7) * 8);
#pragma unroll
          for (int c_ = 0; c_ < NVL; ++c_) rv[c_] = *(const u32x4*)(qkv + krow * ld + vcol + ((tid & 7) * NVL + c_) * 8);
        }
        __syncthreads();
        {
          char* sK0 = smem; char* sV0 = smem + 9216;
          *(u32x4*)(sK0 + lkey * 144 + (tid & 7) * 16) = rk;
#pragma unroll
          for (int c_ = 0; c_ < NVL; ++c_) *(u32x4*)(sV0 + lkey * VS + ((tid & 7) * NVL + c_) * 16) = rv[c_];
        }
        lds_barrier();
        for (int tt = 0; tt < ntl; ++tt) {
          const char* sK = smem + (tt & 1) * TB;
          const char* sV = sK + 9216;
          if (tt + 1 < ntl) {
            const int kst = 16 + 64 * (jlo_blk + tt - 1);
            const size_t krow = (size_t)b * T + kst + lkey;
            rk = *(const u32x4*)(qkv + krow * ld + kcol + (tid & 7) * 8);
#pragma unroll
            for (int c_ = 0; c_ < NVL; ++c_) rv[c_] = *(const u32x4*)(qkv + krow * ld + vcol + ((tid & 7) * NVL + c_) * 8);
          }
          __builtin_amdgcn_sched_barrier(0);
          const int j = jlo_blk + tt - 1;
          const bool active = (tt == 0) || (j >= jlo_w && j <= cq_w);
          if (active) {
            const int start = tt == 0 ? 0 : 16 + 64 * (j - 1);
            const int valid = tt == 0 ? 16 : 64;
            const int qpos = qbase + l31;
            const bool far = (start + 63 - qbase) <= -91;
#pragma unroll
            for (int kb = 0; kb < 2; ++kb) {
              f32x16 S;
#pragma unroll
              for (int i = 0; i < 16; ++i) S[i] = 0.f;
#pragma unroll
              for (int s = 0; s < 4; ++s) {
                bf16x8 a = *(const bf16x8*)(sK + (32 * kb + l31) * 144 + (2 * s + hh) * 16);
                S = mfma32(a, qf[s], S);
              }
              if (far) {
#pragma unroll
                for (int i = 0; i < 16; ++i) S[i] = __expf(S[i] + bfar);
              } else {
#pragma unroll
                for (int i = 0; i < 16; ++i) {
                  const int kl = 32 * kb + crow(i, hh);
                  S[i] = __expf(S[i] + bias_lookup(s_relb, s_btab, start + kl - qpos, bh));
                }
              }
              if (valid < 64) {
#pragma unroll
                for (int i = 0; i < 16; ++i) {
                  const int kl = 32 * kb + crow(i, hh);
                  S[i] = kl < valid ? S[i] : 0.f;
                }
              }
#pragma unroll
              for (int i = 0; i < 16; ++i) l += S[i];
              bf16x8 pf[2];
#pragma unroll
              for (int s2 = 0; s2 < 2; ++s2)
                pf[s2] = mk8(pack2(S[8 * s2], S[8 * s2 + 1]), pack2(S[8 * s2 + 2], S[8 * s2 + 3]),
                             pack2(S[8 * s2 + 4], S[8 * s2 + 5]), pack2(S[8 * s2 + 6], S[8 * s2 + 7]));
#pragma unroll
              for (int d_ = 0; d_ < NDB; ++d_) {
#pragma unroll
                for (int s2 = 0; s2 < 2; ++s2) {
                  const int k0 = 32 * kb + 16 * s2 + 4 * hh + q4;
                  s16x4 lo = tr_read(sV + k0 * VS + (32 * d_ + 16 * blk) * 2 + 8 * p4);
                  s16x4 hi = tr_read(sV + (k0 + 8) * VS + (32 * d_ + 16 * blk) * 2 + 8 * p4);
                  O[d_] = mfma32(cat8(lo, hi), pf[s2], O[d_]);
                }
              }
              __builtin_amdgcn_sched_barrier(0);
            }
          }
          if (tt + 1 < ntl) {
            char* sKn = smem + ((tt + 1) & 1) * TB; char* sVn = sKn + 9216;
            *(u32x4*)(sKn + lkey * 144 + (tid & 7) * 16) = rk;
#pragma unroll
            for (int c_ = 0; c_ < NVL; ++c_) *(u32x4*)(sVn + lkey * VS + ((tid & 7) * NVL + c_) * 16) = rv[c_];
          }
          lds_barrier();
        }
        l += shx(l, 32, lane);
        const bool rowok = qb == 0 ? (w == 0 && l31 < 16) : true;
        if (DIFF) {
          const float inv = 1.f / l;
          if (mm == 0) {
#pragma unroll
            for (int d_ = 0; d_ < NDB; ++d_)
#pragma unroll
              for (int k = 0; k < 8; ++k) s_stash[(d_ * 8 + k) * 64] = pack2(O[d_][2 * k] * inv, O[d_][2 * k + 1] * inv);
          } else {
            float sq = 0.f;
            const float li = lam_full * inv;
#pragma unroll
            for (int d_ = 0; d_ < NDB; ++d_) {
#pragma unroll
              for (int k = 0; k < 8; ++k) {
                const unsigned st_ = s_stash[(d_ * 8 + k) * 64];
                const float x0 = bflo(st_) - li * O[d_][2 * k];
                const float x1 = bfhi(st_) - li * O[d_][2 * k + 1];
                O[d_][2 * k] = x0; O[d_][2 * k + 1] = x1;
                sq = fmaf(x0, x0, sq);
                sq = fmaf(x1, x1, sq);
              }
              __builtin_amdgcn_sched_barrier(0);
            }
            sq += shx(sq, 32, lane);
            const float r = rsqrtf(sq * (1.f / 128.f) + 1e-6f) * (1.f - lam_init);
            if (rowok) {
#pragma unroll
              for (int d_ = 0; d_ < NDB; ++d_) {
#pragma unroll
                for (int g = 0; g < 4; ++g) {
                  const int e = 32 * d_ + 8 * g + 4 * hh;
                  f32x4 sg = *(const f32x4*)(s_sub + e);
                  u32x2 ov = MK2(pack2(O[d_][4 * g] * r * sg[0], O[d_][4 * g + 1] * r * sg[1]),
                                        pack2(O[d_][4 * g + 2] * r * sg[2], O[d_][4 * g + 3] * r * sg[3]));
                  *(u32x2*)(o + qrow * D + hd * 128 + e) = ov;
                }
                __builtin_amdgcn_sched_barrier(0);
              }
            }
          }
        } else {
          l += __expf(sinks[hd]);
          const float inv = 1.f / l;
          if (rowok) {
#pragma unroll
            for (int d_ = 0; d_ < NDB; ++d_)
#pragma unroll
              for (int g = 0; g < 4; ++g) {
                const int e = 32 * d_ + 8 * g + 4 * hh;
                u32x2 ov = MK2(pack2(O[d_][4 * g] * inv, O[d_][4 * g + 1] * inv),
                                      pack2(O[d_][4 * g + 2] * inv, O[d_][4 * g + 3] * inv));
                *(u32x2*)(o + qrow * D + hd * 64 + e) = ov;
              }
          }
        }
      }
    }
  }
  __syncthreads();
}

DI void kvnorm_pass(const float* raw, const float* g1, u16* ckv) {
  const int tid = opaque_tid();
  const int lane = tid & 63, w = __builtin_amdgcn_readfirstlane(tid >> 6);
  f32x4 g = *(const f32x4*)(g1 + lane * 4);
  for (int row = blockIdx.x * 8 + w; row < M; row += gridDim.x * 8) {
    f32x4 v = *(const f32x4*)(raw + (size_t)row * 256 + lane * 4);
    float s = v[0] * v[0] + v[1] * v[1] + v[2] * v[2] + v[3] * v[3];
#pragma unroll
    for (int o_ = 32; o_ >= 1; o_ >>= 1) s += shx(s, o_, lane);
    const float r = rsqrtf(s * (1.f / 256.f) + 1e-6f);
    v = v * g * r;
    *(u32x2*)(ckv + (size_t)row * 256 + lane * 4) = MK2(pack2(v[0], v[1]), pack2(v[2], v[3]));
  }
}

DI void idx_scores(const u16* kidx, const u16* qidx, const float* widx, float* scores) {
  const int tid = opaque_tid(), lane = tid & 63, w = __builtin_amdgcn_readfirstlane(tid >> 6);
  const int l31 = lane & 31, hh = lane >> 5;
  const int nitems = BATCH * 153;
  for (int item = blockIdx.x; item < nitems; item += gridDim.x) {
    const int b = item / 153, r = item % 153;
    int qb = 0;
    while (qb < 8 && 2 * (qb + 1) * (qb + 1) - (qb + 1) <= r) ++qb;
    const int tt = r - (2 * qb * qb - qb);
    const int qbase = qb == 0 ? 32 * w : 16 + 256 * (qb - 1) + 32 * w;
    const int cq_w = qb == 0 ? 0 : 4 * (qb - 1) + 1 + (w >> 1);
    if (tt > cq_w) continue;
    const int start = tt == 0 ? 0 : 16 + 64 * (tt - 1);
    const int valid = tt == 0 ? 16 : 64;
    const size_t qrow = (size_t)b * T + qbase + l31;
    bf16x8 Kf[2][4];
#pragma unroll
    for (int kb = 0; kb < 2; ++kb)
#pragma unroll
      for (int s = 0; s < 4; ++s)
        Kf[kb][s] = *(const bf16x8*)(kidx + ((size_t)b * T + start + 32 * kb + l31) * 64 + 16 * s + 8 * hh);
    f32x16 acc[2];
#pragma unroll
    for (int kb = 0; kb < 2; ++kb)
#pragma unroll
      for (int i = 0; i < 16; ++i) acc[kb][i] = 0.f;
#pragma unroll 1
    for (int hb4 = 0; hb4 < 2; ++hb4) {
      bf16x8 qf[4][4];
      const f32x4 w4 = *(const f32x4*)(widx + qrow * 8 + hb4 * 4);
#pragma unroll
      for (int h = 0; h < 4; ++h)
#pragma unroll
        for (int s = 0; s < 4; ++s) qf[h][s] = *(const bf16x8*)(qidx + qrow * 512 + (hb4 * 4 + h) * 64 + 16 * s + 8 * hh);
#pragma unroll
      for (int h = 0; h < 4; ++h) {
        const float wh = w4[h];
#pragma unroll
        for (int kb = 0; kb < 2; ++kb) {
          f32x16 S;
#pragma unroll
          for (int i = 0; i < 16; ++i) S[i] = 0.f;
#pragma unroll
          for (int s = 0; s < 4; ++s) S = mfma32(Kf[kb][s], qf[h][s], S);
#pragma unroll
          for (int i = 0; i < 16; ++i) acc[kb][i] += wh * fmaxf(S[i], 0.f);
        }
      }
    }
    const bool rowok = qb == 0 ? (w == 0 && l31 < 16) : true;
    if (rowok) {
#pragma unroll
      for (int kb = 0; kb < 2; ++kb)
#pragma unroll
        for (int g = 0; g < 4; ++g) {
          const int kl = 32 * kb + 8 * g + 4 * hh;
          if (kl + 3 < valid) {
            f32x4 v = {acc[kb][4 * g], acc[kb][4 * g + 1], acc[kb][4 * g + 2], acc[kb][4 * g + 3]};
            *(f32x4*)(scores + qrow * SROW + start + kl) = v;
          }
        }
    }
  }
}

DI void topk_select(const float* scores, int* sel, char* smem) {
  const int tid = opaque_tid();
  const int lane = tid & 63, w = __builtin_amdgcn_readfirstlane(tid >> 6);
  unsigned* wsc = (unsigned*)(smem + w * 256);
  for (int row = blockIdx.x * 8 + w; row < M; row += gridDim.x * 8) {
    const int t = row % T;
    const int c = t < 16 ? 0 : 1 + ((t - 16) >> 6);
    const int nvis = 16 + 64 * c;
    if (nvis <= 256) continue;
    unsigned u[33];
    const float* sr = scores + (size_t)row * SROW;
#pragma unroll
    for (int j = 0; j < 33; ++j) {
      const int idx = lane + 64 * j;
      u[j] = __float_as_uint(sr[idx < nvis ? idx : nvis - 1]);
    }
#pragma unroll
    for (int j = 0; j < 33; ++j) {
      const int idx = lane + 64 * j;
      const unsigned bits = u[j];
      u[j] = idx < nvis ? ((bits & 0x80000000u) ? ~bits : (bits | 0x80000000u)) : 0u;
    }
    unsigned prefix = 0;
    for (int bit = 31; bit >= 20; --bit) {
      const unsigned cand = prefix | (1u << bit);
      int cnt = 0;
#pragma unroll
      for (int j = 0; j < 33; ++j) cnt += __builtin_popcountll(__ballot(u[j] >= cand));
      if (cnt >= 256) prefix = cand;
    }
    {
      const unsigned hi = prefix >> 20;
      const unsigned long long lm = (1ull << lane) - 1ull;
      int above = 0, nb = 0;
#pragma unroll
      for (int j = 0; j < 33; ++j) {
        above += __builtin_popcountll(__ballot((u[j] >> 20) > hi));
        const bool pb = (u[j] >> 20) == hi;
        const unsigned long long mb_ = __ballot(pb);
        const int pos = nb + __builtin_popcountll(mb_ & lm);
        if (pb && pos < 64) wsc[pos] = u[j];
        nb += __builtin_popcountll(mb_);
      }
      if (nb <= 64) {
        const int need_rank = 256 - above;
        asm volatile("s_waitcnt lgkmcnt(0)" ::: "memory");
        unsigned cv = wsc[lane];
        cv = lane < nb ? cv : 0u;
        for (int bit = 19; bit >= 0; --bit) {
          const unsigned cand = prefix | (1u << bit);
          if (__builtin_popcountll(__ballot(cv >= cand)) >= need_rank) prefix = cand;
        }
      } else {
        for (int bit = 19; bit >= 0; --bit) {
          const unsigned cand = prefix | (1u << bit);
          int cnt = 0;
#pragma unroll
          for (int j = 0; j < 33; ++j) cnt += __builtin_popcountll(__ballot(u[j] >= cand));
          if (cnt >= 256) prefix = cand;
        }
      }
    }
    int cgt = 0;
#pragma unroll
    for (int j = 0; j < 33; ++j) cgt += __builtin_popcountll(__ballot(u[j] > prefix));
    const int need = 256 - cgt;
    int base = 0, ebase = 0;
    int* so = sel + (size_t)row * 256;
    const unsigned long long lmask = (1ull << lane) - 1ull;
#pragma unroll
    for (int j = 0; j < 33; ++j) {
      const bool pg = u[j] > prefix;
      const unsigned long long mg = __ballot(pg);
      if (pg) so[base + __builtin_popcountll(mg & lmask)] = lane + 64 * j;
      base += __builtin_popcountll(mg);
      const bool pe = u[j] == prefix;
      const unsigned long long me = __ballot(pe);
      const int rk = ebase + __builtin_popcountll(me & lmask);
      if (pe && rk < need) so[cgt + rk] = lane + 64 * j;
      ebase += __builtin_popcountll(me);
    }
  }
}

DI void sparse_attn(const Params& p, u16* qabs, const float* ssq, const u16* ckv, const int* sel, char* smem) {
  constexpr int KS = 544;
  const int tid = opaque_tid(), lane = tid & 63, w = __builtin_amdgcn_readfirstlane(tid >> 6);
  const int g = lane >> 4, h = lane & 15, q4 = (lane & 15) >> 2, p4 = lane & 3;
  char* tl = smem + w * (32 * KS);
  float* s_relb = (float*)(smem + 8 * 32 * KS);
  float* s_gq = s_relb + 512;
  unsigned char* s_btab = (unsigned char*)(s_gq + 256);
  s_relb[tid] = p.relb[tid];
  if (tid < 256) { s_gq[tid] = p.b_qn[tid]; s_btab[tid] = (unsigned char)t5_bucket(tid - 128); }
  __syncthreads();
  for (int row = blockIdx.x * 8 + w; row < M; row += gridDim.x * 8) {
    const int b = row / T, t = row % T;
    const int c = t < 16 ? 0 : 1 + ((t - 16) >> 6);
    const int nvis = 16 + 64 * c;
    const int nsel = nvis < 256 ? nvis : 256;
    const int ntile = (nsel + 31) >> 5;
    const bool use_sel = nvis > 256;
    int h2 = h;
    asm volatile("" : "+v"(h2));
    const float rsq = rsqrtf((ssq[(size_t)row * 32 + 2 * h2] + ssq[(size_t)row * 32 + 2 * h2 + 1]) * (1.f / 256.f) + 1e-6f) * 0.0625f;
    bf16x8 qf[8];
    u16* qrowp = qabs + (size_t)row * 4096 + h2 * 256;
#pragma unroll
    for (int s = 0; s < 8; ++s) {
      u32x4 raw = *(const u32x4*)(qrowp + 32 * s + 8 * g);
      f32x4 g0 = *(const f32x4*)(s_gq + 32 * s + 8 * g), g1 = *(const f32x4*)(s_gq + 32 * s + 8 * g + 4);
      qf[s] = mk8(pack2(bflo(raw[0]) * rsq * g0[0], bfhi(raw[0]) * rsq * g0[1]), pack2(bflo(raw[1]) * rsq * g0[2], bfhi(raw[1]) * rsq * g0[3]),
                  pack2(bflo(raw[2]) * rsq * g1[0], bfhi(raw[2]) * rsq * g1[1]), pack2(bflo(raw[3]) * rsq * g1[2], bfhi(raw[3]) * rsq * g1[3]));
    }
    f32x4 O[16];
#pragma unroll
    for (int rb = 0; rb < 16; ++rb) O[rb] = (f32x4){0.f, 0.f, 0.f, 0.f};
    float l = 0.f;
    int sel4[4];
#pragma unroll
    for (int j4 = 0; j4 < 4; ++j4) sel4[j4] = sel[(size_t)row * 256 + j4 * 64 + lane];
#pragma unroll
    for (int j4 = 0; j4 < 4; ++j4) {
      const int si = j4 * 64 + lane;
      sel4[j4] = si < nsel ? (use_sel ? sel4[j4] : si) : 0;
    }
    u32x4 G[8];
    int selv = shfl_i(sel4[0], lane & 31);
#pragma unroll
    for (int hf = 0; hf < 2; ++hf) {
#pragma unroll
      for (int it = 0; it < 8; ++it) {
        const int kl = 16 * hf + 2 * it + (lane >> 5);
        const int idx = shfl_i(selv, kl);
        G[it] = *(const u32x4*)(ckv + ((size_t)b * T + idx) * 256 + (lane & 31) * 8);
      }
#pragma unroll
      for (int it = 0; it < 8; ++it) *(u32x4*)(tl + (16 * hf + 2 * it + (lane >> 5)) * KS + (lane & 31) * 16) = G[it];
    }
    for (int tile = 0; tile < ntile; ++tile) {
      int selv_n = 0;
      if (tile + 1 < ntile) {
        const int tn_ = tile + 1;
        const int sj = (tn_ >> 1) == 0 ? sel4[0] : ((tn_ >> 1) == 1 ? sel4[1] : ((tn_ >> 1) == 2 ? sel4[2] : sel4[3]));
        selv_n = shfl_i(sj, (tn_ & 1) * 32 + (lane & 31));
#pragma unroll
        for (int it = 0; it < 6; ++it) {
          const int kl = 2 * it + (lane >> 5);
          const int idx = shfl_i(selv_n, kl);
          G[it] = *(const u32x4*)(ckv + ((size_t)b * T + idx) * 256 + (lane & 31) * 8);
        }
      }
      __builtin_amdgcn_sched_barrier(0);
      f32x4 S[2];
#pragma unroll
      for (int mb = 0; mb < 2; ++mb) {
        S[mb] = (f32x4){0.f, 0.f, 0.f, 0.f};
#pragma unroll
        for (int s = 0; s < 8; ++s) {
          bf16x8 a = *(const bf16x8*)(tl + (16 * mb + h) * KS + 64 * s + 16 * g);
          S[mb] = mfma16(a, qf[s], S[mb]);
        }
      }
#pragma unroll
      for (int mb = 0; mb < 2; ++mb)
#pragma unroll
        for (int i = 0; i < 4; ++i) {
          const int kl = 16 * mb + 4 * g + i;
          const int kp = shfl_i(selv, kl);
          const bool ok = tile * 32 + kl < nsel;
          const float pv = ok ? __expf(S[mb][i] + bias_lookup(s_relb, s_btab, kp - t, h)) : 0.f;
          l += pv;
          S[mb][i] = pv;
        }
      bf16x8 pf = mk8(pack2(S[0][0], S[0][1]), pack2(S[0][2], S[0][3]), pack2(S[1][0], S[1][1]), pack2(S[1][2], S[1][3]));
#pragma unroll
      for (int rb = 0; rb < 16; ++rb) {
        s16x4 lo = tr_read(tl + (4 * g + q4) * KS + 32 * rb + 8 * p4);
        s16x4 hi = tr_read(tl + (16 + 4 * g + q4) * KS + 32 * rb + 8 * p4);
        O[rb] = mfma16(cat8(lo, hi), pf, O[rb]);
      }
      __builtin_amdgcn_sched_barrier(0);
      if (tile + 1 < ntile) {
        asm volatile("s_waitcnt lgkmcnt(0)" ::: "memory");
#pragma unroll
        for (int it = 0; it < 6; ++it) *(u32x4*)(tl + (2 * it + (lane >> 5)) * KS + (lane & 31) * 16) = G[it];
        __builtin_amdgcn_sched_barrier(0);
#pragma unroll
        for (int hf = 0; hf < 2; ++hf) {
          u32x4 G2[5];
#pragma unroll
          for (int it = 0; it < 5; ++it) {
            const int kl = 12 + 10 * hf + 2 * it + (lane >> 5);
            const int idx = shfl_i(selv_n, kl);
            G2[it] = *(const u32x4*)(ckv + ((size_t)b * T + idx) * 256 + (lane & 31) * 8);
          }
#pragma unroll
          for (int it = 0; it < 5; ++it) *(u32x4*)(tl + (12 + 10 * hf + 2 * it + (lane >> 5)) * KS + (lane & 31) * 16) = G2[it];
          __builtin_amdgcn_sched_barrier(0);
        }
        selv = selv_n;
      }
    }
    l += shx(l, 16, lane);
    l += shx(l, 32, lane);
    const float inv = 1.f / l;
    int h3 = h;
    asm volatile("" : "+v"(h3));
    u16* qout = qabs + (size_t)row * 4096 + h3 * 256;
#pragma unroll
    for (int rb = 0; rb < 16; ++rb) {
      u32x2 ov = MK2(pack2(O[rb][0] * inv, O[rb][1] * inv), pack2(O[rb][2] * inv, O[rb][3] * inv));
      *(u32x2*)(qout + 16 * rb + 4 * g) = ov;
    }
  }
  __syncthreads();
}

DI void init_h(const Params& p) {
  float* h = (float*)(p.ws + OFF_H);
  u16* hb = (u16*)(p.ws + OFF_HB);
  const size_t n4 = (size_t)M * D / 4;
  for (size_t i = (size_t)blockIdx.x * NT + opaque_tid(); i < n4; i += (size_t)gridDim.x * NT) {
    const size_t e = i * 4;
    const int row = (int)(e / D), col = (int)(e % D);
    const int b = row / T, t = row % T;
    f32x4 v = t < 16 ? *(const f32x4*)(p.meta + (size_t)t * D + col) : *(const f32x4*)(p.x + ((size_t)b * 2048 + (t - 16)) * D + col);
    *(f32x4*)(h + e) = v;
    *(u32x2*)(hb + e) = MK2(pack2(v[0], v[1]), pack2(v[2], v[3]));
  }
}

DI void conv_layer(const Params& p, char* wsb, int layer, char* smem, int part, int rank, int nwork) {
  char* W = wsb + OFF_W;
  if (part & 2) conv_job(p.wo2 + (size_t)layer * DFF * D, D, DFF, D, CV_ID, nullptr, (u16*)(W + W_WO2), smem, rank, nwork);
  if (!(part & 1)) return;
  conv_job(p.wi1 + (size_t)layer * D * 2 * DFF, 2 * DFF, D, 2 * DFF, CV_FFN, p.ln1 + layer * D, (u16*)(W + W_WI1), smem, rank, nwork);
  conv_job(p.wo1 + (size_t)layer * DFF * D, D, DFF, D, CV_ID, nullptr, (u16*)(W + W_WO1), smem, rank, nwork);
  conv_job(p.wi2 + (size_t)layer * D * 2 * DFF, 2 * DFF, D, 2 * DFF, CV_FFN, p.ln2 + layer * D, (u16*)(W + W_WI2), smem, rank, nwork);
  conv_job(p.wout + (size_t)layer * D * D, D, D, D, CV_ID, nullptr, (u16*)(W + W_OUT), smem, rank, nwork);
  const int kind = layer % 3, j = layer / 3;
  const float* lnm = p.lnm + layer * D;
  if (kind == 0) {
    conv_job(p.a_win + (size_t)j * D * 3072, 3072, D, 3072, CV_ID, lnm, (u16*)(W + W_MIX), smem, rank, nwork);
  } else if (kind == 1) {
    conv_job(p.b_win, 584, D, 768, CV_PAD, lnm, (u16*)(W + W_MIX), smem, rank, nwork);
    conv_job(p.b_wuq, 4608, 256, 4608, CV_ID, p.b_lat, (u16*)(W + W_MIX + 1572864), smem, rank, nwork);
    conv_job(p.b_wuv, 64, 1024, 1024, CV_UVBD, nullptr, (u16*)(W + W_MIX + 3932160), smem, rank, nwork);
  } else {
    conv_job(p.c_win, 1280, D, 1280, CV_ID, lnm, (u16*)(W + W_MIX), smem, rank, nwork);
  }
}

enum { G_FFN1_WI = 0, G_FFN1_WO, G_FFN2_WI, G_FFN2_WO, G_A_IN, G_B_IN, G_B_QIDX, G_B_QABS, G_B_UV, G_C_IN, G_WOUT_AC, G_WOUT_B,
       ST_CONV = 32, ST_ATTN_A, ST_ATTN_C, ST_SCORES, ST_TOPK, ST_SPARSE };

DI int step_code(int kind, int st) {
  if (st == 0) return ST_CONV;
  if (st == 1) return G_FFN1_WI;
  if (st == 2) return G_FFN1_WO;
  const int nmix = kind == 1 ? 8 : 3;
  const int ms = st - 3;
  if (ms >= nmix) return ms == nmix ? G_FFN2_WI : G_FFN2_WO;
  if (kind == 0) return ms == 0 ? G_A_IN : (ms == 1 ? ST_ATTN_A : G_WOUT_AC);
  if (kind == 2) return ms == 0 ? G_C_IN : (ms == 1 ? ST_ATTN_C : G_WOUT_AC);
  switch (ms) {
    case 0: return G_B_IN;
    case 1: return G_B_QIDX;
    case 2: return ST_SCORES;
    case 3: return ST_TOPK;
    case 4: return G_B_QABS;
    case 5: return ST_SPARSE;
    case 6: return G_B_UV;
    default: return G_WOUT_B;
  }
}

DI GemmCfg make_cfg(const Params& p, char* wsb, int id, int layer) {
  char* W = wsb + OFF_W;
  char* AR = wsb + OFF_AR;
  const u16* hb = (const u16*)(wsb + OFF_HB);
  const int j = layer / 3;
  GemmCfg c;
  {
    const int z32 = (int)(wsb - p.ws);
    c.A = hb; c.lda = z32; c.a_koff_tn = z32; c.Bt = hb; c.K = z32; c.N = z32; c.epi = z32; c.use_rs = z32;
    c.o16 = (u16*)wsb; c.ldo = z32; c.gain = p.relb; c.nk_end = z32; c.f0 = (float*)wsb; c.o16b = (u16*)wsb; c.f1 = (float*)wsb;
  }
  switch (id) {
    case G_FFN1_WI: case G_FFN2_WI:
      c.A = hb; c.lda = D; c.Bt = (const u16*)(W + (id == G_FFN2_WI ? W_WI2 : W_WI1)); c.K = D; c.N = 2 * DFF; c.epi = EPI_SWIGLU; c.use_rs = 1;
      c.o16 = (u16*)(AR + AR_ACT);
      break;
    case G_FFN1_WO: case G_FFN2_WO:
      c.A = (const u16*)(AR + AR_ACT); c.lda = DFF; c.Bt = (const u16*)(W + (id == G_FFN2_WO ? W_WO2 : W_WO1)); c.K = DFF; c.N = D; c.epi = EPI_RESID;
      break;
    case G_A_IN:
      c.A = hb; c.lda = D; c.Bt = (const u16*)(W + W_MIX); c.K = D; c.N = 3072; c.epi = EPI_QKV; c.use_rs = 1;
      c.o16 = (u16*)(AR + AR_QKV); c.ldo = 3072; c.gain = p.a_qkn + j * 128; c.nk_end = 16;
      break;
    case G_C_IN:
      c.A = hb; c.lda = D; c.Bt = (const u16*)(W + W_MIX); c.K = D; c.N = 1280; c.epi = EPI_QKV; c.use_rs = 1;
      c.o16 = (u16*)(AR + AR_QKV); c.ldo = 1280; c.gain = p.c_qkn; c.nk_end = 9;
      break;
    case G_B_IN:
      c.A = hb; c.lda = D; c.Bt = (const u16*)(W + W_MIX); c.K = D; c.N = 768; c.epi = EPI_B_IN; c.use_rs = 1;
      c.o16 = (u16*)(AR + AR_CQ); c.f0 = (float*)(AR + AR_O_B); c.o16b = (u16*)(AR + AR_KIDX); c.f1 = (float*)(AR + AR_WIDX);
      break;
    case G_B_QIDX:
      c.A = (const u16*)(AR + AR_CQ); c.lda = 256; c.Bt = (const u16*)(W + W_MIX + 1572864) + (size_t)4096 * 256;
      c.K = 256; c.N = 512; c.epi = EPI_QIDX; c.use_rs = 1; c.o16 = (u16*)(AR + AR_QIDX);
      break;
    case G_B_QABS:
      c.A = (const u16*)(AR + AR_CQ); c.lda = 256; c.Bt = (const u16*)(W + W_MIX + 1572864);
      c.K = 256; c.N = 4096; c.epi = EPI_QABS; c.use_rs = 1; c.o16 = (u16*)(AR + AR_BIG); c.f0 = (float*)(AR + AR_SSQ);
      break;
    case G_B_UV:
      c.A = (const u16*)(AR + AR_BIG); c.lda = 4096; c.a_koff_tn = 1024;
      c.Bt = (const u16*)(W + W_MIX + 3932160); c.K = 1024; c.N = 1024; c.epi = EPI_PLAIN; c.use_rs = 0;
      c.o16 = (u16*)(AR + AR_O_B); c.ldo = D;
      break;
    case G_WOUT_AC: case G_WOUT_B:
      c.A = (const u16*)(AR + (id == G_WOUT_B ? AR_O_B : AR_O_AC)); c.lda = D;
      c.Bt = (const u16*)(W + W_OUT); c.K = D; c.N = D; c.epi = EPI_RESID;
      break;
  }
  return c;
}

#ifndef PROBE_DUP
#define PROBE_DUP(code) 0
#endif
__global__ void __launch_bounds__(NT, 2) mega(Params p) {
  cg::grid_group grid = cg::this_grid();
  __shared__ __attribute__((aligned(16))) char smem[SMEM_BYTES];
  __shared__ __attribute__((aligned(16))) unsigned xb_words[4];
  if (threadIdx.x < 4) xb_words[threadIdx.x] = 0u;
  __syncthreads();
  const XcdBarrier xb = xcd_barrier_post((unsigned*)(p.ws + OFF_BAR), (volatile LAS unsigned*)xb_words);
  init_h(p);
  for (int layer = 0; layer < 4; ++layer) {
    const int kind = layer % 3, j = layer / 3;
    const int nsteps = kind == 1 ? 13 : 8;
    for (int st = (layer == 0 ? 0 : 1); st < nsteps; ++st) {
      const int code = step_code(kind, st);
      size_t zoff = 0;
      asm volatile("" : "+s"(zoff));
      char* wsb = p.ws + zoff;
      char* AR = wsb + OFF_AR;
      for (int dup = 0; dup < ((PROBE_DUP(code)) ? 2 : 1); ++dup) {
      if (dup) xcd_barrier(xb);
      if (code < 32) {
        if (code == G_B_QIDX) kvnorm_pass((const float*)(AR + AR_O_B), p.b_lat + 256, (u16*)(AR + AR_CKV));
        const GemmCfg c = make_cfg(p, wsb, code, layer);
        gemm_run(c, smem, (float*)(wsb + OFF_H), (u16*)(wsb + OFF_HB), p.out, (code == G_FFN2_WO && layer == 3) ? 1 : 0);
      }
      {
        const int Gg = gridDim.x;
        const int Lb = ((Gg & 7) == 0) ? (int)(blockIdx.x & 7) * (Gg >> 3) + (int)(blockIdx.x >> 3) : (int)blockIdx.x;
        const int nslow = 0;
        int cl = -1, part = 0, rank = Lb - nslow, nw = Gg - nslow;
        if (code == ST_CONV) { cl = layer; part = 3; rank = (int)blockIdx.x; nw = Gg; }
        else if (code == G_FFN2_WO && layer < 3 && dup == 0) { cl = layer + 1; part = 1; }
        else if (code == G_FFN1_WO && layer > 0 && dup == 0) { cl = layer; part = 2; }
        if (cl >= 0) conv_layer(p, wsb, cl, smem, part, rank, nw);
      }
      if (code < 32 || code == ST_CONV) {
      } else if (code == ST_ATTN_A) {
        const float lam_init = 0.8f - 0.6f * expf(-0.3f * (float)layer);
        attn_dense<128, true>(p, (const u16*)(AR + AR_QKV), 3072, (u16*)(AR + AR_O_AC), p.a_lam + j * 256, p.a_sub + j * 128,
                              lam_init, nullptr, smem);
      } else if (code == ST_ATTN_C) {
        attn_dense<64, false>(p, (const u16*)(AR + AR_QKV), 1280, (u16*)(AR + AR_O_AC), nullptr, nullptr, 0.f, p.c_sink, smem);
      } else if (code == ST_SCORES) {
        idx_scores((const u16*)(AR + AR_KIDX), (const u16*)(AR + AR_QIDX), (const float*)(AR + AR_WIDX), (float*)(AR + AR_BIG));
      } else if (code == ST_TOPK) {
        topk_select((const float*)(AR + AR_BIG), (int*)(AR + AR_SEL), smem);
      } else {
        sparse_attn(p, (u16*)(AR + AR_BIG), (const float*)(AR + AR_SSQ), (const u16*)(AR + AR_CKV), (const int*)(AR + AR_SEL), smem);
      }
      }
      if (layer == 0 && st == 0) grid.sync();
      else xcd_barrier(xb);
    }
  }
}

extern "C" void kernel_launch(void* const* d_in, const int* in_sizes, int n_in, void* d_out, int out_size,
                              void* d_ws, size_t ws_size, hipStream_t stream) {
  static int grid_blocks = 0;
  if (!grid_blocks) {
    int dev = 0, cus = 0, per_cu = 0;
    hipGetDevice(&dev);
    hipDeviceGetAttribute(&cus, hipDeviceAttributeMultiprocessorCount, dev);
    hipOccupancyMaxActiveBlocksPerMultiprocessor(&per_cu, mega, NT, 0);
    if (per_cu > 1) per_cu = 1;
    if (per_cu < 1) per_cu = 1;
    grid_blocks = cus * per_cu;
  }
  if (ws_size < WS_NEED) { fprintf(stderr, "workspace too small: %zu < %zu\n", ws_size, (size_t)WS_NEED); return; }
  Params p{};
  const float* const* in = (const float* const*)d_in;
  p.x = in[0]; p.meta = in[1]; p.relb = in[2]; p.ln1 = in[3]; p.wi1 = in[4]; p.wo1 = in[5]; p.lnm = in[6]; p.wout = in[7];
  p.ln2 = in[8]; p.wi2 = in[9]; p.wo2 = in[10]; p.a_win = in[11]; p.a_qkn = in[12]; p.a_lam = in[13]; p.a_sub = in[14];
  p.b_win = in[15]; p.b_lat = in[16]; p.b_wuq = in[17]; p.b_qn = in[18]; p.b_wuv = in[19]; p.c_win = in[20]; p.c_qkn = in[21];
  p.c_sink = in[22];
  p.out = (float*)d_out; p.ws = (char*)d_ws;
  hipMemsetAsync((char*)d_ws + OFF_BAR, 0, 16384, stream);
  void* args[] = {&p};
  hipError_t e = hipLaunchCooperativeKernel((void*)mega, dim3(grid_blocks), dim3(NT), args, 0, stream);
  if (e != hipSuccess) fprintf(stderr, "cooperative launch failed: %s (grid %d)\n", hipGetErrorString(e), grid_blocks);
}
```

```cpp
#include <hip/hip_runtime.h>
#include <hip/hip_cooperative_groups.h>
#include <cstdio>
namespace cg = cooperative_groups;

#define DI __device__ __forceinline__
typedef unsigned short u16;
typedef __attribute__((ext_vector_type(8))) short bf16x8;
typedef __attribute__((ext_vector_type(4))) short s16x4;
typedef __attribute__((ext_vector_type(16))) float f32x16;
typedef __attribute__((ext_vector_type(4))) float f32x4;
typedef __attribute__((ext_vector_type(2))) float f32x2;
typedef __attribute__((ext_vector_type(2))) __bf16 bf16x2;
typedef __attribute__((ext_vector_type(4))) unsigned u32x4;
typedef __attribute__((ext_vector_type(2))) unsigned u32x2;

constexpr int BATCH = 8, T = 2064, D = 1024, M = BATCH * T, DFF = 2816;
constexpr int SROW = 2080;

constexpr size_t OFF_H = 0;
constexpr size_t OFF_HB = OFF_H + (size_t)M * D * 4;
constexpr size_t OFF_W = OFF_HB + (size_t)M * D * 2;
constexpr size_t W_WI1 = 0, W_WO1 = 11534336, W_WI2 = 17301504, W_WO2 = 28835840, W_OUT = 34603008, W_MIX = 36700160;
constexpr size_t W_TOTAL = 42991616;
constexpr size_t OFF_AR = OFF_W + W_TOTAL;
constexpr size_t AR_ACT = 0;
constexpr size_t AR_QKV = 0;
constexpr size_t AR_O_AC = 101449728;
constexpr size_t AR_BIG = 0;
constexpr size_t AR_O_B = 137379840;
constexpr size_t AR_CQ = 171196416;
constexpr size_t AR_CKV = 179650560;
constexpr size_t AR_KIDX = 188104704;
constexpr size_t AR_WIDX = 190218240;
constexpr size_t AR_QIDX = 190746624;
constexpr size_t AR_SEL = 207654912;
constexpr size_t AR_SSQ = 224563200;
constexpr size_t OFF_BAR = OFF_AR + 226676736;
constexpr size_t WS_NEED = OFF_BAR + 16384;

constexpr int NT = 512;
constexpr int SMEM_BYTES = 4 * 256 * 144 + 1024;

struct Params {
  const float *x, *meta, *relb, *ln1, *wi1, *wo1, *lnm, *wout, *ln2, *wi2, *wo2;
  const float *a_win, *a_qkn, *a_lam, *a_sub, *b_win, *b_lat, *b_wuq, *b_qn, *b_wuv, *c_win, *c_qkn, *c_sink;
  float* out;
  char* ws;
};

#define MK4(a, b, c, d) ((u32x4){(a), (b), (c), (d)})
#define MK2(a, b) ((u32x2){(a), (b)})
DI unsigned pack2(float a, float b) {
  f32x2 v = {a, b};
  bf16x2 r = __builtin_convertvector(v, bf16x2);
  return __builtin_bit_cast(unsigned, r);
}
DI float dot2sq(unsigned v, float c) { bf16x2 a = __builtin_bit_cast(bf16x2, v); return __builtin_amdgcn_fdot2_f32_bf16(a, a, c, false); }
DI float bflo(unsigned v) { return __uint_as_float(v << 16); }
DI float bfhi(unsigned v) { return __uint_as_float(v & 0xffff0000u); }
DI int opaque_tid() { int t = threadIdx.x; asm volatile("" : "+v"(t)); return t; }
DI float shx(float v, int mask, int lane) { return __int_as_float(__builtin_amdgcn_ds_bpermute((lane ^ mask) << 2, __float_as_int(v))); }
DI int shfl_i(int v, int src) { return __builtin_amdgcn_ds_bpermute(src << 2, v); }
DI void lds_barrier() { asm volatile("s_waitcnt lgkmcnt(0)\n\ts_barrier" ::: "memory"); }
DI int crow(int i, int hh) { return (i & 3) + 8 * (i >> 2) + 4 * hh; }
DI f32x16 mfma32(bf16x8 a, bf16x8 b, f32x16 c) { return __builtin_amdgcn_mfma_f32_32x32x16_bf16(a, b, c, 0, 0, 0); }
DI f32x4 mfma16(bf16x8 a, bf16x8 b, f32x4 c) { return __builtin_amdgcn_mfma_f32_16x16x32_bf16(a, b, c, 0, 0, 0); }
DI s16x4 tr_read(const char* p) {
  return __builtin_amdgcn_ds_read_tr16_b64_v4i16((s16x4 __attribute__((address_space(3)))*)(unsigned)(size_t)p);
}
DI bf16x8 cat8(s16x4 lo, s16x4 hi) { return __builtin_shufflevector(lo, hi, 0, 1, 2, 3, 4, 5, 6, 7); }
DI bf16x8 mk8(unsigned a, unsigned b, unsigned c, unsigned d) {
  u32x4 u = MK4(a, b, c, d);
  return __builtin_bit_cast(bf16x8, u);
}
constexpr float LOG2E = 1.4426950408889634f;
DI int t5_bucket(int rel) {
  int n = rel < 0 ? -rel : rel;
  int b = (n < 8 ? n : 8) + (n >= 12) + (n >= 16) + (n >= 23) + (n >= 32) + (n >= 46) + (n >= 64) + (n >= 91);
  return b + (rel > 0 ? 16 : 0);
}
DI float bias_lookup(const float* s_relb, const unsigned char* btab, int rel, int head) {
  const int idx = (rel < -128 ? -128 : (rel > 127 ? 127 : rel)) + 128;
  return s_relb[(int)btab[idx] * 16 + head];
}


#define XB_TMO      128
#define XB_XCNT(j)  (256  + 64 * (j))
#define XB_XSUB(j)  (1280 + 64 * (j))
#define XB_XGEN(j)  (2304 + 64 * (j))
#define XB_TOP      3328
#define XB_TOPGEN   3392
#define XCD_BAR_WORDS 3456
#define XB_SPIN_CAP (1u << 22)
#define LAS __attribute__((address_space(3)))
DI unsigned xb_ld(unsigned* p) { return __hip_atomic_load(p, __ATOMIC_RELAXED, __HIP_MEMORY_SCOPE_AGENT); }
DI unsigned xb_add(unsigned* p, unsigned v) { return __hip_atomic_fetch_add(p, v, __ATOMIC_RELAXED, __HIP_MEMORY_SCOPE_AGENT); }
DI unsigned xb_xcc_id() { return (unsigned)__builtin_amdgcn_s_getreg((3 << 11) | 20) & 0xFu; }
#define XB_SPIN(cond, bar) do { unsigned _sp = 0; while (cond) { __builtin_amdgcn_s_sleep(1); \
    if ((++_sp & 255u) == 0u) { if (xb_ld(&(bar)[XB_TMO])) break; if (_sp > XB_SPIN_CAP) { atomicAdd(&(bar)[XB_TMO], 1u); break; } } } } while (0)
struct XcdBarrier { unsigned* bar; unsigned x; volatile LAS unsigned* st; };
DI XcdBarrier xcd_barrier_post(unsigned* bar, volatile LAS unsigned* st) {
  XcdBarrier b; b.bar = bar; b.x = xb_xcc_id(); b.st = st;
  if (threadIdx.x == 0) (void)xb_add(&bar[XB_XCNT(b.x)], 1u);
  return b;
}
DI void xcd_barrier_complete(unsigned* bar, unsigned x, unsigned& nloc, unsigned& nx) {
  const unsigned G = gridDim.x * gridDim.y * gridDim.z;
  unsigned sum, cnt, mine, sp = 0u;
  for (;;) {
    sum = 0u; cnt = 0u; mine = 0u;
#pragma unroll
    for (unsigned j = 0; j < 16; ++j) { const unsigned c = xb_ld(&bar[XB_XCNT(j)]); sum += c; cnt += (c > 0u) ? 1u : 0u; mine = (j == x) ? c : mine; }
    if (sum == G) break;
    __builtin_amdgcn_s_sleep(1);
    if ((++sp & 255u) == 0u) { if (xb_ld(&bar[XB_TMO])) break; if (sp > XB_SPIN_CAP) { atomicAdd(&bar[XB_TMO], 1u); break; } }
  }
  nloc = mine > 0u ? mine : 1u; nx = cnt > 0u ? cnt : 1u;
}
DI void xcd_barrier(const XcdBarrier& b) {
  asm volatile("s_waitcnt vmcnt(0)" ::: "memory");
  __syncthreads();
  if (threadIdx.x == 0) {
    unsigned* bar = b.bar;
    __builtin_amdgcn_s_waitcnt(0);
    unsigned nloc = b.st[0], nx = b.st[1];
    if (nloc == 0u) { xcd_barrier_complete(bar, b.x, nloc, nx); b.st[0] = nloc; b.st[1] = nx; }
    const unsigned old = xb_add(&bar[XB_XSUB(b.x)], 1u);
    const unsigned gen = old / nloc;
    if (old + 1u == (gen + 1u) * nloc) {
      __builtin_amdgcn_fence(__ATOMIC_RELEASE, "agent");
      asm volatile("s_waitcnt vmcnt(0)" ::: "memory");
      const unsigned og = xb_add(&bar[XB_TOP], 1u);
      const unsigned tg = og / nx;
      if (og + 1u == (tg + 1u) * nx) xb_add(&bar[XB_TOPGEN], 1u);
      else XB_SPIN(xb_ld(&bar[XB_TOPGEN]) == tg, bar);
      __builtin_amdgcn_fence(__ATOMIC_ACQUIRE, "agent");
      xb_add(&bar[XB_XGEN(b.x)], 1u);
      asm volatile("s_waitcnt vmcnt(0)" ::: "memory");
    } else {
      XB_SPIN(xb_ld(&bar[XB_XGEN(b.x)]) == gen, bar);
      __builtin_amdgcn_fence(__ATOMIC_ACQUIRE, "agent");
      asm volatile("s_waitcnt vmcnt(0)" ::: "memory");
    }
  }
  __syncthreads();
}

enum { CV_ID = 0, CV_PAD = 1, CV_FFN = 2, CV_UVBD = 3 };
DI float conv_src(const float* src, int ld, int kind, int k, int n) {
  if (kind == CV_ID) return src[(size_t)k * ld + n];
  if (kind == CV_PAD) return n < ld ? src[(size_t)k * ld + n] : 0.f;
  if (kind == CV_FFN) {
    int tile = n >> 7, j = n & 127;
    int col = j < 64 ? tile * 64 + j : DFF + tile * 64 + (j - 64);
    return src[(size_t)k * ld + col];
  }
  int h = n >> 6, d = n & 63;
  return ((k >> 8) == (h & 3)) ? src[((size_t)h * 256 + (k & 255)) * 64 + d] : 0.f;
}
DI void conv_job(const float* src, int ld, int K, int N, int kind, const float* gain, u16* dst, char* smem, int rank, int nwork) {
  float* lds = (float*)smem;
  const int tid = opaque_tid();
  const int tk_n = K >> 7, tn_n = N >> 6;
  if (rank < 0) return;
  for (int tile = rank; tile < tk_n * tn_n; tile += nwork) {
    const int tk = tile % tk_n, tn = tile / tk_n;
    const int k0 = tk * 128, n0 = tn * 64;
    const int nn = tid & 63;
    float cv[16];
#pragma unroll
    for (int i = 0; i < 16; ++i) cv[i] = conv_src(src, ld, kind, k0 + (tid >> 6) + 8 * i, n0 + nn);
    if (gain) {
      float gv[16];
#pragma unroll
      for (int i = 0; i < 16; ++i) gv[i] = gain[k0 + (tid >> 6) + 8 * i];
#pragma unroll
      for (int i = 0; i < 16; ++i) cv[i] *= gv[i];
    }
#pragma unroll
    for (int i = 0; i < 16; ++i) lds[nn * 129 + (tid >> 6) + 8 * i] = cv[i];
    __syncthreads();
    {
      const int n2 = tid >> 3, ks = (tid & 7) * 16;
      const float* r = lds + n2 * 129 + ks;
      u32x4 o0 = MK4(pack2(r[0], r[1]), pack2(r[2], r[3]), pack2(r[4], r[5]), pack2(r[6], r[7]));
      u32x4 o1 = MK4(pack2(r[8], r[9]), pack2(r[10], r[11]), pack2(r[12], r[13]), pack2(r[14], r[15]));
      u32x4* d4 = (u32x4*)(dst + (size_t)(n0 + n2) * K + k0 + ks);
      d4[0] = o0; d4[1] = o1;
    }
    __syncthreads();
  }
}

enum { EPI_SWIGLU = 0, EPI_RESID, EPI_QKV, EPI_B_IN, EPI_QIDX, EPI_QABS, EPI_PLAIN };
struct GemmCfg {
  const u16* A; int lda; int a_koff_tn; const u16* Bt; int K; int N; int epi; int use_rs;
  u16* o16; int ldo;
  const float* gain; int nk_end;
  float* f0; u16* o16b; float* f1;
};

DI void epi_slab(const GemmCfg c, const f32x16 (&acc)[4], float* sW, const float* rss, const size_t row0, const int g, const int lane,
                 float* const g_h, u16* const g_hb, float* const g_out, const int final_out) {
  int ln_ = lane;
  asm volatile("" : "+v"(ln_));
  const int l31 = ln_ & 31, hh = ln_ >> 5;
#pragma unroll
  for (int nb = 0; nb < 4; ++nb)
#pragma unroll
    for (int i = 0; i < 16; ++i) sW[crow(i, hh) * 132 + nb * 32 + l31] = acc[nb][i];
  asm volatile("s_waitcnt lgkmcnt(0)" ::: "memory");
  const int K = c.K;
  const float invK = 1.0f / (float)K;
  if (c.epi == EPI_SWIGLU) {
    const int c4 = (ln_ & 15) * 4;
#pragma unroll 2
    for (int it = 0; it < 8; ++it) {
      const int r = (ln_ >> 4) + 4 * it;
      const float rs = rsqrtf(rss[r] * invK + 1e-6f);
      f32x4 a = *(const f32x4*)(sW + r * 132 + c4);
      f32x4 b = *(const f32x4*)(sW + r * 132 + 64 + c4);
      float y[4];
#pragma unroll
      for (int e = 0; e < 4; ++e) { float av = a[e] * rs, bv = b[e] * rs; y[e] = av * __builtin_amdgcn_rcpf(1.f + __expf(-av)) * bv; }
      *(u32x2*)(c.o16 + (row0 + r) * DFF + g * 64 + c4) = MK2(pack2(y[0], y[1]), pack2(y[2], y[3]));
    }
  } else if (c.epi == EPI_RESID) {
    const int c4 = l31 * 4;
    const int col = g * 128 + c4;
    const float sc = (K == DFF ? 0.5f : 1.f);
#pragma unroll
    for (int hb_ = 0; hb_ < 2; ++hb_) {
      f32x4 hv[8];
#pragma unroll
      for (int i8 = 0; i8 < 8; ++i8) hv[i8] = *(const f32x4*)(g_h + (row0 + hh + 2 * (hb_ * 8 + i8)) * D + col);
#pragma unroll
      for (int i8 = 0; i8 < 8; ++i8) {
        const int r = hh + 2 * (hb_ * 8 + i8);
        const size_t row = row0 + r;
        f32x4 v = *(const f32x4*)(sW + r * 132 + c4);
        f32x4 o = hv[i8] + v * sc;
        *(f32x4*)(g_h + row * D + col) = o;
        *(u32x2*)(g_hb + row * D + col) = MK2(pack2(o[0], o[1]), pack2(o[2], o[3]));
        if (final_out) {
          const int b = (int)(row / T), t = (int)(row % T);
          if (t >= 16) *(f32x4*)(g_out + ((size_t)b * 2048 + (t - 16)) * D + col) = o;
        }
      }
    }
  } else {
    const int c4 = l31 * 4;
    const int col = g * 128 + c4;
#pragma unroll 2
    for (int it = 0; it < 16; ++it) {
      const int r = hh + 2 * it;
      const size_t row = row0 + r;
      f32x4 v = *(const f32x4*)(sW + r * 132 + c4);
      const float rs = c.use_rs ? rsqrtf(rss[r] * invK + 1e-6f) : 1.f;
      if (c.epi == EPI_QKV) {
        f32x4 x = v * rs;
        float s = x[0] * x[0] + x[1] * x[1] + x[2] * x[2] + x[3] * x[3];
        s += shx(s, 1, ln_); s += shx(s, 2, ln_); s += shx(s, 4, ln_); s += shx(s, 8, ln_);
        if (g < c.nk_end) {
          const float r2 = rsqrtf(s * (1.f / 64.f) + 1e-6f) * (g < 8 ? 0.125f * LOG2E : 1.f);
          f32x4 gn = *(const f32x4*)(c.gain + (g < 8 ? 0 : 64) + (c4 & 63));
          x = x * gn * r2;
        }
        *(u32x2*)(c.o16 + row * c.ldo + col) = MK2(pack2(x[0], x[1]), pack2(x[2], x[3]));
      } else if (c.epi == EPI_B_IN) {
        f32x4 x = v * rs;
        float s = x[0] * x[0] + x[1] * x[1] + x[2] * x[2] + x[3] * x[3];
        s += shx(s, 1, ln_); s += shx(s, 2, ln_); s += shx(s, 4, ln_); s += shx(s, 8, ln_);
        if (g < 2) {
          *(u32x2*)(c.o16 + row * 256 + col) = MK2(pack2(x[0], x[1]), pack2(x[2], x[3]));
        } else if (g < 4) {
          *(f32x4*)(c.f0 + row * 256 + (col - 256)) = x;
        } else if (g == 4 && c4 < 64) {
          const float r2 = rsqrtf(s * (1.f / 64.f) + 1e-6f);
          x = x * r2;
          *(u32x2*)(c.o16b + row * 64 + c4) = MK2(pack2(x[0], x[1]), pack2(x[2], x[3]));
        } else if (g == 4 && c4 < 72) {
          *(f32x4*)(c.f1 + row * 8 + (c4 - 64)) = x * 0.35355339059327373f;
        }
      } else if (c.epi == EPI_QIDX) {
        f32x4 x = v * (rs * 0.125f);
        *(u32x2*)(c.o16 + row * 512 + col) = MK2(pack2(x[0], x[1]), pack2(x[2], x[3]));
      } else if (c.epi == EPI_QABS) {
        f32x4 x = v * rs;
        float s = x[0] * x[0] + x[1] * x[1] + x[2] * x[2] + x[3] * x[3];
        s += shx(s, 1, ln_); s += shx(s, 2, ln_); s += shx(s, 4, ln_); s += shx(s, 8, ln_); s += shx(s, 16, ln_);
        if (l31 == 0) c.f0[row * 32 + g] = s;
        *(u32x2*)(c.o16 + row * 4096 + col) = MK2(pack2(x[0], x[1]), pack2(x[2], x[3]));
      } else {
        *(u32x2*)(c.o16 + row * c.ldo + col) = MK2(pack2(v[0], v[1]), pack2(v[2], v[3]));
      }
    }
  }
  asm volatile("s_waitcnt lgkmcnt(0)" ::: "memory");
}

constexpr int GTS = 256 * 144;
DI void gemm_run(const GemmCfg c, char* smem, float* const g_h, u16* const g_hb, float* const g_out, const int final_out) {
  const int tid = opaque_tid(), lane = tid & 63, w = __builtin_amdgcn_readfirstlane(tid >> 6), wm = w >> 1, wn = w & 1;
  const int l31 = lane & 31, hh = lane >> 5;
  float* s_rowss = (float*)(smem + 4 * GTS);
  float* sW = (float*)(smem + w * (32 * 132 * 4));
  const int tilesN = c.N >> 8;
  const int K = c.K, nk = K >> 6;
  const int G = gridDim.x;
  const bool tail16 = (tilesN == 4) && (G == 256) && (c.epi == EPI_RESID || c.epi == EPI_PLAIN);
  const int ntiles = (tail16 ? 64 : 65) * tilesN;
  const int lrow = tid >> 3, lch = tid & 7;
  const int Lb = ((G & 7) == 0) ? (int)(blockIdx.x & 7) * (G >> 3) + (int)(blockIdx.x >> 3) : (int)blockIdx.x;
  const int srow = 8 * tilesN;
  for (int slot = Lb; slot < ntiles; slot += G) {
    const int sr = slot / srow, idx = slot - sr * srow;
    const int tm = sr < 8 ? sr * 8 + (idx & 7) : 64;
    const int tn = sr < 8 ? (idx >> 3) : idx;
    const u16* Ag = c.A + (size_t)(tm * 256 + lrow) * c.lda + tn * c.a_koff_tn + lch * 8;
    const u16* Bg = c.Bt + (size_t)(tn * 256 + lrow) * K + lch * 8;
    const size_t astep = (size_t)64 * c.lda, bstep = (size_t)64 * K;
    f32x16 acc[2][4];
#pragma unroll
    for (int a = 0; a < 2; ++a)
#pragma unroll
      for (int b = 0; b < 4; ++b)
#pragma unroll
        for (int i = 0; i < 16; ++i) acc[a][b][i] = 0.f;
    float ss[4] = {0.f, 0.f, 0.f, 0.f};
    u32x4 ra0[4], rb0[4];
#define G_LOAD(RA, RB, KT) { size_t as_ = astep, bs_ = bstep; asm volatile("" : "+s"(as_), "+s"(bs_)); \
      _Pragma("unroll") for (int i = 0; i < 4; ++i) { RA[i] = *(const u32x4*)(Ag + i * as_ + (KT) * 64); RB[i] = *(const u32x4*)(Bg + i * bs_ + (KT) * 64); } }
#define G_STORE(RA, RB, BUF) { _Pragma("unroll") for (int i = 0; i < 4; ++i) { \
      *(u32x4*)(smem + (BUF) * GTS + (lrow + 64 * i) * 144 + lch * 16) = RA[i]; \
      *(u32x4*)(smem + 2 * GTS + (BUF) * GTS + (lrow + 64 * i) * 144 + lch * 16) = RB[i]; } \
      _Pragma("unroll") for (int i = 0; i < 4; ++i) \
        ss[i] = dot2sq(RA[i][3], dot2sq(RA[i][2], dot2sq(RA[i][1], dot2sq(RA[i][0], ss[i])))); }
#define K_FRAG(S, FA, FB) { \
        _Pragma("unroll") for (int q_ = 0; q_ < 2; ++q_) FA[q_] = *(const bf16x8*)(sAc + (wm * 64 + q_ * 32 + l31) * 144 + (2 * (S) + hh) * 16); \
        _Pragma("unroll") for (int q_ = 0; q_ < 4; ++q_) FB[q_] = *(const bf16x8*)(sBc + (wn * 128 + q_ * 32 + l31) * 144 + (2 * (S) + hh) * 16); }
#define K_STEP(CUR, NXT, KTL, DOSTORE, DOLOAD) { \
      const char* sAc = smem + (CUR) * GTS; const char* sBc = smem + 2 * GTS + (CUR) * GTS; \
      size_t as_ = astep, bs_ = bstep; asm volatile("" : "+s"(as_), "+s"(bs_)); \
      _Pragma("unroll") for (int s = 0; s < 4; ++s) { \
        bf16x8 fa[1][2], fb[1][4]; \
        K_FRAG(s, fa[0], fb[0]); \
        if (DOSTORE) { \
          *(u32x4*)(smem + (NXT) * GTS + (lrow + 64 * s) * 144 + lch * 16) = ra0[s]; \
          *(u32x4*)(smem + 2 * GTS + (NXT) * GTS + (lrow + 64 * s) * 144 + lch * 16) = rb0[s]; \
          ss[s] = dot2sq(ra0[s][3], dot2sq(ra0[s][2], dot2sq(ra0[s][1], dot2sq(ra0[s][0], ss[s])))); } \
        if (DOLOAD) { ra0[s] = *(const u32x4*)(Ag + s * as_ + (KTL) * 64); rb0[s] = *(const u32x4*)(Bg + s * bs_ + (KTL) * 64); } \
        _Pragma("unroll") for (int mb = 0; mb < 2; ++mb) \
          _Pragma("unroll") for (int nb = 0; nb < 4; ++nb) acc[mb][nb] = mfma32(fa[0][mb], fb[0][nb], acc[mb][nb]); \
        __builtin_amdgcn_sched_group_barrier(0x100, 6, 0); \
        __builtin_amdgcn_sched_group_barrier(0x008, 1, 0); __builtin_amdgcn_sched_group_barrier(0x200, 1, 0); \
        __builtin_amdgcn_sched_group_barrier(0x008, 1, 0); __builtin_amdgcn_sched_group_barrier(0x200, 1, 0); \
        __builtin_amdgcn_sched_group_barrier(0x008, 1, 0); __builtin_amdgcn_sched_group_barrier(0x002, 4, 0); \
        __builtin_amdgcn_sched_group_barrier(0x008, 1, 0); __builtin_amdgcn_sched_group_barrier(0x020, 1, 0); \
        __builtin_amdgcn_sched_group_barrier(0x008, 1, 0); __builtin_amdgcn_sched_group_barrier(0x020, 1, 0); \
        __builtin_amdgcn_sched_group_barrier(0x008, 3, 0); \
        __builtin_amdgcn_sched_barrier(0); } }
    G_LOAD(ra0, rb0, 0);
    __syncthreads();
    G_STORE(ra0, rb0, 0);
    G_LOAD(ra0, rb0, 1);
    lds_barrier();
    int kt = 0;
    for (; kt + 3 < nk; kt += 2) {
      K_STEP(0, 1, kt + 2, true, true);
      lds_barrier();
      K_STEP(1, 0, kt + 3, true, true);
      lds_barrier();
    }
    K_STEP(0, 1, 0, true, false);
    lds_barrier();
    K_STEP(1, 0, 0, false, false);
    lds_barrier();
#undef K_STEP
#undef K_FRAG
#undef G_LOAD
#undef G_STORE
    if (c.use_rs) {
#pragma unroll
      for (int i = 0; i < 4; ++i) {
        float s_ = ss[i];
        s_ += shx(s_, 1, lane); s_ += shx(s_, 2, lane); s_ += shx(s_, 4, lane);
        if (lch == 0) s_rowss[lrow + 64 * i] = s_;
      }
    }
    __syncthreads();
#pragma unroll
    for (int mb = 0; mb < 2; ++mb) {
      const size_t row0 = (size_t)tm * 256 + wm * 64 + mb * 32;
      if (row0 < (size_t)M) epi_slab(c, acc[mb], sW, s_rowss + wm * 64 + mb * 32, row0, tn * 2 + wn, lane, g_h, g_hb, g_out, final_out);
    }
  }
  __syncthreads();
  if (tail16) {
    float* sP = (float*)smem;
    const int l15 = lane & 15, kq = lane >> 4;
    const int Kw = K >> 3;
    for (int t = (int)blockIdx.x; t < 512; t += G) {
      const int rg = t & 7, cg = t >> 3;
      const u16* Ap = c.A + (size_t)(16384 + rg * 16 + l15) * c.lda + (cg >> 4) * c.a_koff_tn + w * Kw + kq * 8;
      const u16* Bp = c.Bt + (size_t)(cg * 16 + l15) * K + w * Kw + kq * 8;
      f32x4 a4 = {0.f, 0.f, 0.f, 0.f};
#pragma unroll 4
      for (int k = 0; k < Kw; k += 32) {
        bf16x8 av = *(const bf16x8*)(Ap + k);
        bf16x8 bv = *(const bf16x8*)(Bp + k);
        a4 = mfma16(av, bv, a4);
      }
#pragma unroll
      for (int i = 0; i < 4; ++i) sP[w * 256 + (kq * 4 + i) * 16 + l15] = a4[i];
      __syncthreads();
      if (tid < 256) {
        const float v = ((sP[tid] + sP[256 + tid]) + (sP[512 + tid] + sP[768 + tid])) + ((sP[1024 + tid] + sP[1280 + tid]) + (sP[1536 + tid] + sP[1792 + tid]));
        const size_t row = 16384 + rg * 16 + (tid >> 4);
        const int col = cg * 16 + (tid & 15);
        if (c.epi == EPI_RESID) {
          const float o = g_h[row * D + col] + v * (K == DFF ? 0.5f : 1.f);
          g_h[row * D + col] = o;
          g_hb[row * D + col] = (u16)(pack2(o, o) & 0xffffu);
          if (final_out) {
            const int b = (int)(row / T), t2 = (int)(row % T);
            if (t2 >= 16) g_out[((size_t)b * 2048 + (t2 - 16)) * D + col] = o;
          }
        } else {
          c.o16[row * c.ldo + col] = (u16)(pack2(v, v) & 0xffffu);
        }
      }
      __syncthreads();
    }
  }
  __syncthreads();
}

template <int VD, bool DIFF>
DI void attn_dense(const Params& p, const u16* qkv, int ld, u16* o, const float* lam4, const float* subln,
                           float lam_init, const float* sinks, char* smem) {
  constexpr int VS = VD * 2 + 64;
  constexpr int NDB = VD / 32;
  constexpr int NVL = VD / 64;
  constexpr int TB = 9216 + 64 * VS;
  float* s_relb = (float*)(smem + 2 * TB);
  const int tid = opaque_tid(), lane = tid & 63, w = __builtin_amdgcn_readfirstlane(tid >> 6);
  unsigned* s_stash = (unsigned*)(smem + 2 * TB + 2048) + w * 2048 + lane;
  const int l31 = lane & 31, hh = lane >> 5;
  const int q4 = (lane & 15) >> 2, p4 = lane & 3, blk = (lane >> 4) & 1;
  unsigned char* s_btab = (unsigned char*)(smem + 2 * TB + 2048 + 65536);
  if (tid < 512) s_relb[tid] = p.relb[tid] * LOG2E;
  if (tid < 256) s_btab[tid] = (unsigned char)t5_bucket(tid - 128);
  float* s_sub = (float*)(smem + 2 * TB + 2048 + 65536 + 256);
  if (DIFF && tid < 128) s_sub[tid] = subln[tid];
  float lam_full = 0.f;
  if (DIFF) {
    float v1 = lam4[lane] * lam4[64 + lane], v2 = lam4[128 + lane] * lam4[192 + lane];
#pragma unroll
    for (int o_ = 32; o_ >= 1; o_ >>= 1) { v1 += shx(v1, o_, lane); v2 += shx(v2, o_, lane); }
    lam_full = __expf(v1) - __expf(v2) + lam_init;
  }
  __syncthreads();
  constexpr int NH = DIFF ? 8 : 16;
  const int nitems = DIFF ? (256 + 64) : (BATCH * NH * 9);
  for (int item = blockIdx.x; item < nitems; item += gridDim.x) {
    int b, hd, qb0, nrep;
    if (DIFF) {
      if (item < 256) { const int pi = item >> 6; b = (item >> 3) & 7; hd = item & 7; qb0 = 8 - pi; nrep = 2; }
      else { const int r = item - 256; b = r >> 3; hd = r & 7; qb0 = 0; nrep = 1; }
    } else {
      qb0 = 8 - item / (BATCH * NH); const int r = item % (BATCH * NH); b = r / NH; hd = r % NH; nrep = 1;
    }
    for (int rep = 0; rep < nrep; ++rep) {
      const int qb = rep == 0 ? qb0 : 9 - qb0;
      const int qbase = qb == 0 ? 32 * w : 16 + 256 * (qb - 1) + 32 * w;
      const int cq_w = qb == 0 ? 0 : 4 * (qb - 1) + 1 + (w >> 1);
      const int cq_max = qb == 0 ? 0 : 4 * qb;
      const int jlo_blk = DIFF ? 1 : (qb == 0 ? 1 : (4 * qb - 5 > 1 ? 4 * qb - 5 : 1));
      const int jlo_w = DIFF ? 1 : (cq_w - 2 > 1 ? cq_w - 2 : 1);
      const int ntl = 1 + (cq_max >= jlo_blk ? cq_max - jlo_blk + 1 : 0);
      const size_t qrow = (size_t)b * T + qbase + l31;
      const int vcol = DIFF ? 2048 + hd * 128 : 1152 + (hd >> 3) * 64;
      for (int mm = 0; mm < (DIFF ? 2 : 1); ++mm) {
        const int qcol = DIFF ? hd * 128 + mm * 64 : hd * 64;
        const int kcol = DIFF ? 1024 + hd * 128 + mm * 64 : 1024 + (hd >> 3) * 64;
        const int bh = DIFF ? mm * 8 + hd : hd;
        bf16x8 qf[4];
#pragma unroll
        for (int s = 0; s < 4; ++s) qf[s] = *(const bf16x8*)(qkv + qrow * ld + qcol + 16 * s + 8 * hh);
        f32x16 O[NDB];
#pragma unroll
        for (int d_ = 0; d_ < NDB; ++d_)
#pragma unroll
          for (int i = 0; i < 16; ++i) O[d_][i] = 0.f;
        float l = 0.f;
        const float bfar = s_relb[15 * 16 + bh];
        const int lkey = tid >> 3;
        u32x4 rk, rv[NVL];
        {
          const size_t krow = (size_t)b * T + lkey;
          rk = *(const u32x4*)(qkv + krow * ld + kcol + (tid & 7) * 8);
#pragma unroll
          for (int c_ = 0; c_ < NVL; ++c_) rv[c_] = *(const u32x4*)(qkv + krow * ld + vcol + ((tid & 7) * NVL + c_) * 8);
        }
        __syncthreads();
        {
          char* sK0 = smem; char* sV0 = smem + 9216;
          *(u32x4*)(sK0 + lkey * 144 + (tid & 7) * 16) = rk;
#pragma unroll
          for (int c_ = 0; c_ < NVL; ++c_) *(u32x4*)(sV0 + lkey * VS + ((tid & 7) * NVL + c_) * 16) = rv[c_];
        }
        lds_barrier();
        for (int tt = 0; tt < ntl; ++tt) {
          const char* sK = smem + (tt & 1) * TB;
          const char* sV = sK + 9216;
          if (tt + 1 < ntl) {
            const int kst = 16 + 64 * (jlo_blk + tt - 1);
            const size_t krow = (size_t)b * T + kst + lkey;
            rk = *(const u32x4*)(qkv + krow * ld + kcol + (tid & 7) * 8);
#pragma unroll
            for (int c_ = 0; c_ < NVL; ++c_) rv[c_] = *(const u32x4*)(qkv + krow * ld + vcol + ((tid & 7) * NVL + c_) * 8);
          }
          __builtin_amdgcn_sched_barrier(0);
          const int j = jlo_blk + tt - 1;
          const bool active = (tt == 0) || (j >= jlo_w && j <= cq_w);
          if (active) {
            const int start = tt == 0 ? 0 : 16 + 64 * (j - 1);
            const int valid = tt == 0 ? 16 : 64;
            const int qpos = qbase + l31;
            const bool far = (start + 63 - qbase) <= -91;
#pragma unroll
            for (int kb = 0; kb < 2; ++kb) {
              f32x16 S;
#pragma unroll
              for (int i = 0; i < 16; ++i) S[i] = 0.f;
#pragma unroll
              for (int s = 0; s < 4; ++s) {
                bf16x8 a = *(const bf16x8*)(sK + (32 * kb + l31) * 144 + (2 * s + hh) * 16);
                S = mfma32(a, qf[s], S);
              }
              if (far) {
#pragma unroll
                for (int i = 0; i < 16; ++i) S[i] = __builtin_amdgcn_exp2f(S[i] + bfar);
              } else {
#pragma unroll
                for (int i = 0; i < 16; ++i) {
                  const int kl = 32 * kb + crow(i, hh);
                  S[i] = __builtin_amdgcn_exp2f(S[i] + bias_lookup(s_relb, s_btab, start + kl - qpos, bh));
                }
              }
              if (valid < 64) {
#pragma unroll
                for (int i = 0; i < 16; ++i) {
                  const int kl = 32 * kb + crow(i, hh);
                  S[i] = kl < valid ? S[i] : 0.f;
                }
              }
#pragma unroll
              for (int i = 0; i < 16; ++i) l += S[i];
              bf16x8 pf[2];
#pragma unroll
              for (int s2 = 0; s2 < 2; ++s2)
                pf[s2] = mk8(pack2(S[8 * s2], S[8 * s2 + 1]), pack2(S[8 * s2 + 2], S[8 * s2 + 3]),
                             pack2(S[8 * s2 + 4], S[8 * s2 + 5]), pack2(S[8 * s2 + 6], S[8 * s2 + 7]));
#pragma unroll
              for (int d_ = 0; d_ < NDB; ++d_) {
#pragma unroll
                for (int s2 = 0; s2 < 2; ++s2) {
                  const int k0 = 32 * kb + 16 * s2 + 4 * hh + q4;
                  s16x4 lo = tr_read(sV + k0 * VS + (32 * d_ + 16 * blk) * 2 + 8 * p4);
                  s16x4 hi = tr_read(sV + (k0 + 8) * VS + (32 * d_ + 16 * blk) * 2 + 8 * p4);
                  O[d_] = mfma32(cat8(lo, hi), pf[s2], O[d_]);
                }
              }
              __builtin_amdgcn_sched_barrier(0);
            }
          }
          if (tt + 1 < ntl) {
            char* sKn = smem + ((tt + 1) & 1) * TB; char* sVn = sKn + 9216;
            *(u32x4*)(sKn + lkey * 144 + (tid & 7) * 16) = rk;
#pragma unroll
            for (int c_ = 0; c_ < NVL; ++c_) *(u32x4*)(sVn + lkey * VS + ((tid & 7) * NVL + c_) * 16) = rv[c_];
          }
          lds_barrier();
        }
        l += shx(l, 32, lane);
        const bool rowok = qb == 0 ? (w == 0 && l31 < 16) : true;
        if (DIFF) {
          const float inv = 1.f / l;
          if (mm == 0) {
#pragma unroll
            for (int d_ = 0; d_ < NDB; ++d_)
#pragma unroll
              for (int k = 0; k < 8; ++k) s_stash[(d_ * 8 + k) * 64] = pack2(O[d_][2 * k] * inv, O[d_][2 * k + 1] * inv);
          } else {
            float sq = 0.f;
            const float li = lam_full * inv;
#pragma unroll
            for (int d_ = 0; d_ < NDB; ++d_) {
#pragma unroll
              for (int k = 0; k < 8; ++k) {
                const unsigned st_ = s_stash[(d_ * 8 + k) * 64];
                const float x0 = bflo(st_) - li * O[d_][2 * k];
                const float x1 = bfhi(st_) - li * O[d_][2 * k + 1];
                O[d_][2 * k] = x0; O[d_][2 * k + 1] = x1;
                sq = fmaf(x0, x0, sq);
                sq = fmaf(x1, x1, sq);
              }
              __builtin_amdgcn_sched_barrier(0);
            }
            sq += shx(sq, 32, lane);
            const float r = rsqrtf(sq * (1.f / 128.f) + 1e-6f) * (1.f - lam_init);
            if (rowok) {
#pragma unroll
              for (int d_ = 0; d_ < NDB; ++d_) {
#pragma unroll
                for (int g = 0; g < 4; ++g) {
                  const int e = 32 * d_ + 8 * g + 4 * hh;
                  f32x4 sg = *(const f32x4*)(s_sub + e);
                  u32x2 ov = MK2(pack2(O[d_][4 * g] * r * sg[0], O[d_][4 * g + 1] * r * sg[1]),
                                        pack2(O[d_][4 * g + 2] * r * sg[2], O[d_][4 * g + 3] * r * sg[3]));
                  *(u32x2*)(o + qrow * D + hd * 128 + e) = ov;
                }
                __builtin_amdgcn_sched_barrier(0);
              }
            }
          }
        } else {
          l += __expf(sinks[hd]);
          const float inv = 1.f / l;
          if (rowok) {
#pragma unroll
            for (int d_ = 0; d_ < NDB; ++d_)
#pragma unroll
              for (int g = 0; g < 4; ++g) {
                const int e = 32 * d_ + 8 * g + 4 * hh;
                u32x2 ov = MK2(pack2(O[d_][4 * g] * inv, O[d_][4 * g + 1] * inv),
                                      pack2(O[d_][4 * g + 2] * inv, O[d_][4 * g + 3] * inv));
                *(u32x2*)(o + qrow * D + hd * 64 + e) = ov;
              }
          }
        }
      }
    }
  }
  __syncthreads();
}

DI void kvnorm_pass(const float* raw, const float* g1, u16* ckv) {
  const int tid = opaque_tid();
  const int lane = tid & 63, w = __builtin_amdgcn_readfirstlane(tid >> 6);
  f32x4 g = *(const f32x4*)(g1 + lane * 4);
  for (int row = blockIdx.x * 8 + w; row < M; row += gridDim.x * 8) {
    f32x4 v = *(const f32x4*)(raw + (size_t)row * 256 + lane * 4);
    float s = v[0] * v[0] + v[1] * v[1] + v[2] * v[2] + v[3] * v[3];
#pragma unroll
    for (int o_ = 32; o_ >= 1; o_ >>= 1) s += shx(s, o_, lane);
    const float r = rsqrtf(s * (1.f / 256.f) + 1e-6f);
    v = v * g * r;
    *(u32x2*)(ckv + (size_t)row * 256 + lane * 4) = MK2(pack2(v[0], v[1]), pack2(v[2], v[3]));
  }
}

DI void idx_scores(const u16* kidx, const u16* qidx, const float* widx, float* scores) {
  const int tid = opaque_tid(), lane = tid & 63, w = __builtin_amdgcn_readfirstlane(tid >> 6);
  const int l31 = lane & 31, hh = lane >> 5;
  const int nitems = BATCH * 153;
  for (int item = blockIdx.x; item < nitems; item += gridDim.x) {
    const int b = item / 153, r = item % 153;
    int qb = 0;
    while (qb < 8 && 2 * (qb + 1) * (qb + 1) - (qb + 1) <= r) ++qb;
    const int tt = r - (2 * qb * qb - qb);
    const int qbase = qb == 0 ? 32 * w : 16 + 256 * (qb - 1) + 32 * w;
    const int cq_w = qb == 0 ? 0 : 4 * (qb - 1) + 1 + (w >> 1);
    if (tt > cq_w) continue;
    const int start = tt == 0 ? 0 : 16 + 64 * (tt - 1);
    const int valid = tt == 0 ? 16 : 64;
    const size_t qrow = (size_t)b * T + qbase + l31;
    bf16x8 Kf[2][4];
#pragma unroll
    for (int kb = 0; kb < 2; ++kb)
#pragma unroll
      for (int s = 0; s < 4; ++s)
        Kf[kb][s] = *(const bf16x8*)(kidx + ((size_t)b * T + start + 32 * kb + l31) * 64 + 16 * s + 8 * hh);
    f32x16 acc[2];
#pragma unroll
    for (int kb = 0; kb < 2; ++kb)
#pragma unroll
      for (int i = 0; i < 16; ++i) acc[kb][i] = 0.f;
#pragma unroll 1
    for (int hb4 = 0; hb4 < 2; ++hb4) {
      bf16x8 qf[4][4];
      const f32x4 w4 = *(const f32x4*)(widx + qrow * 8 + hb4 * 4);
#pragma unroll
      for (int h = 0; h < 4; ++h)
#pragma unroll
        for (int s = 0; s < 4; ++s) qf[h][s] = *(const bf16x8*)(qidx + qrow * 512 + (hb4 * 4 + h) * 64 + 16 * s + 8 * hh);
#pragma unroll
      for (int h = 0; h < 4; ++h) {
        const float wh = w4[h];
#pragma unroll
        for (int kb = 0; kb < 2; ++kb) {
          f32x16 S;
#pragma unroll
          for (int i = 0; i < 16; ++i) S[i] = 0.f;
#pragma unroll
          for (int s = 0; s < 4; ++s) S = mfma32(Kf[kb][s], qf[h][s], S);
#pragma unroll
          for (int i = 0; i < 16; ++i) acc[kb][i] += wh * fmaxf(S[i], 0.f);
        }
      }
    }
    const bool rowok = qb == 0 ? (w == 0 && l31 < 16) : true;
    if (rowok) {
#pragma unroll
      for (int kb = 0; kb < 2; ++kb)
#pragma unroll
        for (int g = 0; g < 4; ++g) {
          const int kl = 32 * kb + 8 * g + 4 * hh;
          if (kl + 3 < valid) {
            f32x4 v = {acc[kb][4 * g], acc[kb][4 * g + 1], acc[kb][4 * g + 2], acc[kb][4 * g + 3]};
            *(f32x4*)(scores + qrow * SROW + start + kl) = v;
          }
        }
    }
  }
}

DI void topk_select(const float* scores, int* sel, char* smem) {
  const int tid = opaque_tid();
  const int lane = tid & 63, w = __builtin_amdgcn_readfirstlane(tid >> 6);
  unsigned* wsc = (unsigned*)(smem + w * 256);
  for (int row = blockIdx.x * 8 + w; row < M; row += gridDim.x * 8) {
    const int t = row % T;
    const int c = t < 16 ? 0 : 1 + ((t - 16) >> 6);
    const int nvis = 16 + 64 * c;
    if (nvis <= 256) continue;
    unsigned u[33];
    const float* sr = scores + (size_t)row * SROW;
#pragma unroll
    for (int j = 0; j < 33; ++j) {
      const int idx = lane + 64 * j;
      u[j] = __float_as_uint(sr[idx < nvis ? idx : nvis - 1]);
    }
#pragma unroll
    for (int j = 0; j < 33; ++j) {
      const int idx = lane + 64 * j;
      const unsigned bits = u[j];
      u[j] = idx < nvis ? ((bits & 0x80000000u) ? ~bits : (bits | 0x80000000u)) : 0u;
    }
    unsigned prefix = 0;
    for (int bit = 31; bit >= 20; --bit) {
      const unsigned cand = prefix | (1u << bit);
      int cnt = 0;
#pragma unroll
      for (int j = 0; j < 33; ++j) cnt += __builtin_popcountll(__ballot(u[j] >= cand));
      if (cnt >= 256) prefix = cand;
    }
    {
      const unsigned hi = prefix >> 20;
      const unsigned long long lm = (1ull << lane) - 1ull;
      int above = 0, nb = 0;
#pragma unroll
      for (int j = 0; j < 33; ++j) {
        above += __builtin_popcountll(__ballot((u[j] >> 20) > hi));
        const bool pb = (u[j] >> 20) == hi;
        const unsigned long long mb_ = __ballot(pb);
        const int pos = nb + __builtin_popcountll(mb_ & lm);
        if (pb && pos < 64) wsc[pos] = u[j];
        nb += __builtin_popcountll(mb_);
      }
      if (nb <= 64) {
        const int need_rank = 256 - above;
        asm volatile("s_waitcnt lgkmcnt(0)" ::: "memory");
        unsigned cv = wsc[lane];
        cv = lane < nb ? cv : 0u;
        for (int bit = 19; bit >= 0; --bit) {
          const unsigned cand = prefix | (1u << bit);
          if (__builtin_popcountll(__ballot(cv >= cand)) >= need_rank) prefix = cand;
        }
      } else {
        for (int bit = 19; bit >= 0; --bit) {
          const unsigned cand = prefix | (1u << bit);
          int cnt = 0;
#pragma unroll
          for (int j = 0; j < 33; ++j) cnt += __builtin_popcountll(__ballot(u[j] >= cand));
          if (cnt >= 256) prefix = cand;
        }
      }
    }
    int cgt = 0;
#pragma unroll
    for (int j = 0; j < 33; ++j) cgt += __builtin_popcountll(__ballot(u[j] > prefix));
    const int need = 256 - cgt;
    int base = 0, ebase = 0;
    int* so = sel + (size_t)row * 256;
    const unsigned long long lmask = (1ull << lane) - 1ull;
#pragma unroll
    for (int j = 0; j < 33; ++j) {
      const bool pg = u[j] > prefix;
      const unsigned long long mg = __ballot(pg);
      if (pg) so[base + __builtin_popcountll(mg & lmask)] = lane + 64 * j;
      base += __builtin_popcountll(mg);
      const bool pe = u[j] == prefix;
      const unsigned long long me = __ballot(pe);
      const int rk = ebase + __builtin_popcountll(me & lmask);
      if (pe && rk < need) so[cgt + rk] = lane + 64 * j;
      ebase += __builtin_popcountll(me);
    }
  }
}

DI void sparse_attn(const Params& p, u16* qabs, const float* ssq, const u16* ckv, const int* sel, char* smem) {
  constexpr int KS = 544;
  const int tid = opaque_tid(), lane = tid & 63, w = __builtin_amdgcn_readfirstlane(tid >> 6);
  const int g = lane >> 4, h = lane & 15, q4 = (lane & 15) >> 2, p4 = lane & 3;
  char* tl = smem + w * (32 * KS);
  float* s_relb = (float*)(smem + 8 * 32 * KS);
  float* s_gq = s_relb + 512;
  unsigned char* s_btab = (unsigned char*)(s_gq + 256);
  s_relb[tid] = p.relb[tid] * LOG2E;
  if (tid < 256) { s_gq[tid] = p.b_qn[tid]; s_btab[tid] = (unsigned char)t5_bucket(tid - 128); }
  __syncthreads();
  for (int row = blockIdx.x * 8 + w; row < M; row += gridDim.x * 8) {
    const int b = row / T, t = row % T;
    const int c = t < 16 ? 0 : 1 + ((t - 16) >> 6);
    const int nvis = 16 + 64 * c;
    const int nsel = nvis < 256 ? nvis : 256;
    const int ntile = (nsel + 31) >> 5;
    const bool use_sel = nvis > 256;
    int h2 = h;
    asm volatile("" : "+v"(h2));
    const float rsq = rsqrtf((ssq[(size_t)row * 32 + 2 * h2] + ssq[(size_t)row * 32 + 2 * h2 + 1]) * (1.f / 256.f) + 1e-6f) * (0.0625f * LOG2E);
    bf16x8 qf[8];
    u16* qrowp = qabs + (size_t)row * 4096 + h2 * 256;
#pragma unroll
    for (int s = 0; s < 8; ++s) {
      u32x4 raw = *(const u32x4*)(qrowp + 32 * s + 8 * g);
      f32x4 g0 = *(const f32x4*)(s_gq + 32 * s + 8 * g), g1 = *(const f32x4*)(s_gq + 32 * s + 8 * g + 4);
      qf[s] = mk8(pack2(bflo(raw[0]) * rsq * g0[0], bfhi(raw[0]) * rsq * g0[1]), pack2(bflo(raw[1]) * rsq * g0[2], bfhi(raw[1]) * rsq * g0[3]),
                  pack2(bflo(raw[2]) * rsq * g1[0], bfhi(raw[2]) * rsq * g1[1]), pack2(bflo(raw[3]) * rsq * g1[2], bfhi(raw[3]) * rsq * g1[3]));
    }
    f32x4 O[16];
#pragma unroll
    for (int rb = 0; rb < 16; ++rb) O[rb] = (f32x4){0.f, 0.f, 0.f, 0.f};
    float l = 0.f;
    int sel4[4];
#pragma unroll
    for (int j4 = 0; j4 < 4; ++j4) sel4[j4] = sel[(size_t)row * 256 + j4 * 64 + lane];
#pragma unroll
    for (int j4 = 0; j4 < 4; ++j4) {
      const int si = j4 * 64 + lane;
      sel4[j4] = si < nsel ? (use_sel ? sel4[j4] : si) : 0;
    }
    u32x4 G[8];
    int selv = shfl_i(sel4[0], lane & 31);
#pragma unroll
    for (int hf = 0; hf < 2; ++hf) {
#pragma unroll
      for (int it = 0; it < 8; ++it) {
        const int kl = 16 * hf + 2 * it + (lane >> 5);
        const int idx = shfl_i(selv, kl);
        G[it] = *(const u32x4*)(ckv + ((size_t)b * T + idx) * 256 + (lane & 31) * 8);
      }
#pragma unroll
      for (int it = 0; it < 8; ++it) *(u32x4*)(tl + (16 * hf + 2 * it + (lane >> 5)) * KS + (lane & 31) * 16) = G[it];
    }
    for (int tile = 0; tile < ntile; ++tile) {
      int selv_n = 0;
      if (tile + 1 < ntile) {
        const int tn_ = tile + 1;
        const int sj = (tn_ >> 1) == 0 ? sel4[0] : ((tn_ >> 1) == 1 ? sel4[1] : ((tn_ >> 1) == 2 ? sel4[2] : sel4[3]));
        selv_n = shfl_i(sj, (tn_ & 1) * 32 + (lane & 31));
#pragma unroll
        for (int it = 0; it < 6; ++it) {
          const int kl = 2 * it + (lane >> 5);
          const int idx = shfl_i(selv_n, kl);
          G[it] = *(const u32x4*)(ckv + ((size_t)b * T + idx) * 256 + (lane & 31) * 8);
        }
      }
      __builtin_amdgcn_sched_barrier(0);
      f32x4 S[2];
#pragma unroll
      for (int mb = 0; mb < 2; ++mb) {
        S[mb] = (f32x4){0.f, 0.f, 0.f, 0.f};
#pragma unroll
        for (int s = 0; s < 8; ++s) {
          bf16x8 a = *(const bf16x8*)(tl + (16 * mb + h) * KS + 64 * s + 16 * g);
          S[mb] = mfma16(a, qf[s], S[mb]);
        }
      }
#pragma unroll
      for (int mb = 0; mb < 2; ++mb)
#pragma unroll
        for (int i = 0; i < 4; ++i) {
          const int kl = 16 * mb + 4 * g + i;
          const int kp = shfl_i(selv, kl);
          const float okf = (tile * 32 + kl < nsel) ? 1.f : 0.f;
          const float pv = __builtin_amdgcn_exp2f(S[mb][i] + bias_lookup(s_relb, s_btab, kp - t, h)) * okf;
          l += pv;
          S[mb][i] = pv;
        }
      bf16x8 pf = mk8(pack2(S[0][0], S[0][1]), pack2(S[0][2], S[0][3]), pack2(S[1][0], S[1][1]), pack2(S[1][2], S[1][3]));
#pragma unroll
      for (int rb = 0; rb < 16; ++rb) {
        s16x4 lo = tr_read(tl + (4 * g + q4) * KS + 32 * rb + 8 * p4);
        s16x4 hi = tr_read(tl + (16 + 4 * g + q4) * KS + 32 * rb + 8 * p4);
        O[rb] = mfma16(cat8(lo, hi), pf, O[rb]);
      }
      __builtin_amdgcn_sched_barrier(0);
      if (tile + 1 < ntile) {
        asm volatile("s_waitcnt lgkmcnt(0)" ::: "memory");
#pragma unroll
        for (int it = 0; it < 6; ++it) *(u32x4*)(tl + (2 * it + (lane >> 5)) * KS + (lane & 31) * 16) = G[it];
        __builtin_amdgcn_sched_barrier(0);
#pragma unroll
        for (int hf = 0; hf < 2; ++hf) {
          u32x4 G2[5];
#pragma unroll
          for (int it = 0; it < 5; ++it) {
            const int kl = 12 + 10 * hf + 2 * it + (lane >> 5);
            const int idx = shfl_i(selv_n, kl);
            G2[it] = *(const u32x4*)(ckv + ((size_t)b * T + idx) * 256 + (lane & 31) * 8);
          }
#pragma unroll
          for (int it = 0; it < 5; ++it) *(u32x4*)(tl + (12 + 10 * hf + 2 * it + (lane >> 5)) * KS + (lane & 31) * 16) = G2[it];
          __builtin_amdgcn_sched_barrier(0);
        }
        selv = selv_n;
      }
    }
    l += shx(l, 16, lane);
    l += shx(l, 32, lane);
    const float inv = 1.f / l;
    int h3 = h;
    asm volatile("" : "+v"(h3));
    u16* qout = qabs + (size_t)row * 4096 + h3 * 256;
#pragma unroll
    for (int rb = 0; rb < 16; ++rb) {
      u32x2 ov = MK2(pack2(O[rb][0] * inv, O[rb][1] * inv), pack2(O[rb][2] * inv, O[rb][3] * inv));
      *(u32x2*)(qout + 16 * rb + 4 * g) = ov;
    }
  }
  __syncthreads();
}

DI void init_h(const Params& p) {
  float* h = (float*)(p.ws + OFF_H);
  u16* hb = (u16*)(p.ws + OFF_HB);
  const size_t n4 = (size_t)M * D / 4;
  for (size_t i = (size_t)blockIdx.x * NT + opaque_tid(); i < n4; i += (size_t)gridDim.x * NT) {
    const size_t e = i * 4;
    const int row = (int)(e / D), col = (int)(e % D);
    const int b = row / T, t = row % T;
    f32x4 v = t < 16 ? *(const f32x4*)(p.meta + (size_t)t * D + col) : *(const f32x4*)(p.x + ((size_t)b * 2048 + (t - 16)) * D + col);
    *(f32x4*)(h + e) = v;
    *(u32x2*)(hb + e) = MK2(pack2(v[0], v[1]), pack2(v[2], v[3]));
  }
}

DI void conv_layer(const Params& p, char* wsb, int layer, char* smem, int part, int rank, int nwork) {
  char* W = wsb + OFF_W;
  if (part & 2) conv_job(p.wo2 + (size_t)layer * DFF * D, D, DFF, D, CV_ID, nullptr, (u16*)(W + W_WO2), smem, rank, nwork);
  if (!(part & 1)) return;
  conv_job(p.wi1 + (size_t)layer * D * 2 * DFF, 2 * DFF, D, 2 * DFF, CV_FFN, p.ln1 + layer * D, (u16*)(W + W_WI1), smem, rank, nwork);
  conv_job(p.wo1 + (size_t)layer * DFF * D, D, DFF, D, CV_ID, nullptr, (u16*)(W + W_WO1), smem, rank, nwork);
  conv_job(p.wi2 + (size_t)layer * D * 2 * DFF, 2 * DFF, D, 2 * DFF, CV_FFN, p.ln2 + layer * D, (u16*)(W + W_WI2), smem, rank, nwork);
  conv_job(p.wout + (size_t)layer * D * D, D, D, D, CV_ID, nullptr, (u16*)(W + W_OUT), smem, rank, nwork);
  const int kind = layer % 3, j = layer / 3;
  const float* lnm = p.lnm + layer * D;
  if (kind == 0) {
    conv_job(p.a_win + (size_t)j * D * 3072, 3072, D, 3072, CV_ID, lnm, (u16*)(W + W_MIX), smem, rank, nwork);
  } else if (kind == 1) {
    conv_job(p.b_win, 584, D, 768, CV_PAD, lnm, (u16*)(W + W_MIX), smem, rank, nwork);
    conv_job(p.b_wuq, 4608, 256, 4608, CV_ID, p.b_lat, (u16*)(W + W_MIX + 1572864), smem, rank, nwork);
    conv_job(p.b_wuv, 64, 1024, 1024, CV_UVBD, nullptr, (u16*)(W + W_MIX + 3932160), smem, rank, nwork);
  } else {
    conv_job(p.c_win, 1280, D, 1280, CV_ID, lnm, (u16*)(W + W_MIX), smem, rank, nwork);
  }
}

enum { G_FFN1_WI = 0, G_FFN1_WO, G_FFN2_WI, G_FFN2_WO, G_A_IN, G_B_IN, G_B_QIDX, G_B_QABS, G_B_UV, G_C_IN, G_WOUT_AC, G_WOUT_B,
       ST_CONV = 32, ST_ATTN_A, ST_ATTN_C, ST_SCORES, ST_TOPK, ST_SPARSE };

DI int step_code(int kind, int st) {
  if (st == 0) return ST_CONV;
  if (st == 1) return G_FFN1_WI;
  if (st == 2) return G_FFN1_WO;
  const int nmix = kind == 1 ? 8 : 3;
  const int ms = st - 3;
  if (ms >= nmix) return ms == nmix ? G_FFN2_WI : G_FFN2_WO;
  if (kind == 0) return ms == 0 ? G_A_IN : (ms == 1 ? ST_ATTN_A : G_WOUT_AC);
  if (kind == 2) return ms == 0 ? G_C_IN : (ms == 1 ? ST_ATTN_C : G_WOUT_AC);
  switch (ms) {
    case 0: return G_B_IN;
    case 1: return G_B_QIDX;
    case 2: return ST_SCORES;
    case 3: return ST_TOPK;
    case 4: return G_B_QABS;
    case 5: return ST_SPARSE;
    case 6: return G_B_UV;
    default: return G_WOUT_B;
  }
}

DI GemmCfg make_cfg(const Params& p, char* wsb, int id, int layer) {
  char* W = wsb + OFF_W;
  char* AR = wsb + OFF_AR;
  const u16* hb = (const u16*)(wsb + OFF_HB);
  const int j = layer / 3;
  GemmCfg c;
  {
    const int z32 = (int)(wsb - p.ws);
    c.A = hb; c.lda = z32; c.a_koff_tn = z32; c.Bt = hb; c.K = z32; c.N = z32; c.epi = z32; c.use_rs = z32;
    c.o16 = (u16*)wsb; c.ldo = z32; c.gain = p.relb; c.nk_end = z32; c.f0 = (float*)wsb; c.o16b = (u16*)wsb; c.f1 = (float*)wsb;
  }
  switch (id) {
    case G_FFN1_WI: case G_FFN2_WI:
      c.A = hb; c.lda = D; c.Bt = (const u16*)(W + (id == G_FFN2_WI ? W_WI2 : W_WI1)); c.K = D; c.N = 2 * DFF; c.epi = EPI_SWIGLU; c.use_rs = 1;
      c.o16 = (u16*)(AR + AR_ACT);
      break;
    case G_FFN1_WO: case G_FFN2_WO:
      c.A = (const u16*)(AR + AR_ACT); c.lda = DFF; c.Bt = (const u16*)(W + (id == G_FFN2_WO ? W_WO2 : W_WO1)); c.K = DFF; c.N = D; c.epi = EPI_RESID;
      break;
    case G_A_IN:
      c.A = hb; c.lda = D; c.Bt = (const u16*)(W + W_MIX); c.K = D; c.N = 3072; c.epi = EPI_QKV; c.use_rs = 1;
      c.o16 = (u16*)(AR + AR_QKV); c.ldo = 3072; c.gain = p.a_qkn + j * 128; c.nk_end = 16;
      break;
    case G_C_IN:
      c.A = hb; c.lda = D; c.Bt = (const u16*)(W + W_MIX); c.K = D; c.N = 1280; c.epi = EPI_QKV; c.use_rs = 1;
      c.o16 = (u16*)(AR + AR_QKV); c.ldo = 1280; c.gain = p.c_qkn; c.nk_end = 9;
      break;
    case G_B_IN:
      c.A = hb; c.lda = D; c.Bt = (const u16*)(W + W_MIX); c.K = D; c.N = 768; c.epi = EPI_B_IN; c.use_rs = 1;
      c.o16 = (u16*)(AR + AR_CQ); c.f0 = (float*)(AR + AR_O_B); c.o16b = (u16*)(AR + AR_KIDX); c.f1 = (float*)(AR + AR_WIDX);
      break;
    case G_B_QIDX:
      c.A = (const u16*)(AR + AR_CQ); c.lda = 256; c.Bt = (const u16*)(W + W_MIX + 1572864) + (size_t)4096 * 256;
      c.K = 256; c.N = 512; c.epi = EPI_QIDX; c.use_rs = 1; c.o16 = (u16*)(AR + AR_QIDX);
      break;
    case G_B_QABS:
      c.A = (const u16*)(AR + AR_CQ); c.lda = 256; c.Bt = (const u16*)(W + W_MIX + 1572864);
      c.K = 256; c.N = 4096; c.epi = EPI_QABS; c.use_rs = 1; c.o16 = (u16*)(AR + AR_BIG); c.f0 = (float*)(AR + AR_SSQ);
      break;
    case G_B_UV:
      c.A = (const u16*)(AR + AR_BIG); c.lda = 4096; c.a_koff_tn = 1024;
      c.Bt = (const u16*)(W + W_MIX + 3932160); c.K = 1024; c.N = 1024; c.epi = EPI_PLAIN; c.use_rs = 0;
      c.o16 = (u16*)(AR + AR_O_B); c.ldo = D;
      break;
    case G_WOUT_AC: case G_WOUT_B:
      c.A = (const u16*)(AR + (id == G_WOUT_B ? AR_O_B : AR_O_AC)); c.lda = D;
      c.Bt = (const u16*)(W + W_OUT); c.K = D; c.N = D; c.epi = EPI_RESID;
      break;
  }
  return c;
}

#ifndef PROBE_DUP
#define PROBE_DUP(code) 0
#endif
__global__ void __launch_bounds__(NT, 2) mega(Params p) {
  cg::grid_group grid = cg::this_grid();
  __shared__ __attribute__((aligned(16))) char smem[SMEM_BYTES];
  __shared__ __attribute__((aligned(16))) unsigned xb_words[4];
  if (threadIdx.x < 4) xb_words[threadIdx.x] = 0u;
  __syncthreads();
  const XcdBarrier xb = xcd_barrier_post((unsigned*)(p.ws + OFF_BAR), (volatile LAS unsigned*)xb_words);
  init_h(p);
  for (int layer = 0; layer < 4; ++layer) {
    const int kind = layer % 3, j = layer / 3;
    const int nsteps = kind == 1 ? 13 : 8;
    for (int st = (layer == 0 ? 0 : 1); st < nsteps; ++st) {
      const int code = step_code(kind, st);
      size_t zoff = 0;
      asm volatile("" : "+s"(zoff));
      char* wsb = p.ws + zoff;
      char* AR = wsb + OFF_AR;
      for (int dup = 0; dup < ((PROBE_DUP(code)) ? 2 : 1); ++dup) {
      if (dup) xcd_barrier(xb);
      if (code < 32) {
        if (code == G_B_QIDX) kvnorm_pass((const float*)(AR + AR_O_B), p.b_lat + 256, (u16*)(AR + AR_CKV));
        const GemmCfg c = make_cfg(p, wsb, code, layer);
        gemm_run(c, smem, (float*)(wsb + OFF_H), (u16*)(wsb + OFF_HB), p.out, (code == G_FFN2_WO && layer == 3) ? 1 : 0);
      }
      {
        const int Gg = gridDim.x;
        const int Lb = ((Gg & 7) == 0) ? (int)(blockIdx.x & 7) * (Gg >> 3) + (int)(blockIdx.x >> 3) : (int)blockIdx.x;
        const int nslow = 0;
        int cl = -1, part = 0, rank = Lb - nslow, nw = Gg - nslow;
        if (code == ST_CONV) { cl = layer; part = 3; rank = (int)blockIdx.x; nw = Gg; }
        else if (code == G_FFN2_WO && layer < 3 && dup == 0) { cl = layer + 1; part = 1; }
        else if (code == G_FFN1_WO && layer > 0 && dup == 0) { cl = layer; part = 2; }
        if (cl >= 0) conv_layer(p, wsb, cl, smem, part, rank, nw);
      }
      if (code < 32 || code == ST_CONV) {
      } else if (code == ST_ATTN_A) {
        const float lam_init = 0.8f - 0.6f * expf(-0.3f * (float)layer);
        attn_dense<128, true>(p, (const u16*)(AR + AR_QKV), 3072, (u16*)(AR + AR_O_AC), p.a_lam + j * 256, p.a_sub + j * 128,
                              lam_init, nullptr, smem);
      } else if (code == ST_ATTN_C) {
        attn_dense<64, false>(p, (const u16*)(AR + AR_QKV), 1280, (u16*)(AR + AR_O_AC), nullptr, nullptr, 0.f, p.c_sink, smem);
      } else if (code == ST_SCORES) {
        idx_scores((const u16*)(AR + AR_KIDX), (const u16*)(AR + AR_QIDX), (const float*)(AR + AR_WIDX), (float*)(AR + AR_BIG));
      } else if (code == ST_TOPK) {
        topk_select((const float*)(AR + AR_BIG), (int*)(AR + AR_SEL), smem);
      } else {
        sparse_attn(p, (u16*)(AR + AR_BIG), (const float*)(AR + AR_SSQ), (const u16*)(AR + AR_CKV), (const int*)(AR + AR_SEL), smem);
      }
      }
      if (layer == 0 && st == 0) grid.sync();
      else xcd_barrier(xb);
    }
  }
}

extern "C" void kernel_launch(void* const* d_in, const int* in_sizes, int n_in, void* d_out, int out_size,
                              void* d_ws, size_t ws_size, hipStream_t stream) {
  static int grid_blocks = 0;
  if (!grid_blocks) {
    int dev = 0, cus = 0, per_cu = 0;
    hipGetDevice(&dev);
    hipDeviceGetAttribute(&cus, hipDeviceAttributeMultiprocessorCount, dev);
    hipOccupancyMaxActiveBlocksPerMultiprocessor(&per_cu, mega, NT, 0);
    if (per_cu > 1) per_cu = 1;
    if (per_cu < 1) per_cu = 1;
    grid_blocks = cus * per_cu;
  }
  if (ws_size < WS_NEED) { fprintf(stderr, "workspace too small: %zu < %zu\n", ws_size, (size_t)WS_NEED); return; }
  Params p{};
  const float* const* in = (const float* const*)d_in;
  p.x = in[0]; p.meta = in[1]; p.relb = in[2]; p.ln1 = in[3]; p.wi1 = in[4]; p.wo1 = in[5]; p.lnm = in[6]; p.wout = in[7];
  p.ln2 = in[8]; p.wi2 = in[9]; p.wo2 = in[10]; p.a_win = in[11]; p.a_qkn = in[12]; p.a_lam = in[13]; p.a_sub = in[14];
  p.b_win = in[15]; p.b_lat = in[16]; p.b_wuq = in[17]; p.b_qn = in[18]; p.b_wuv = in[19]; p.c_win = in[20]; p.c_qkn = in[21];
  p.c_sink = in[22];
  p.out = (float*)d_out; p.ws = (char*)d_ws;
  hipMemsetAsync((char*)d_ws + OFF_BAR, 0, 16384, stream);
  void* args[] = {&p};
  hipError_t e = hipLaunchCooperativeKernel((void*)mega, dim3(grid_blocks), dim3(NT), args, 0, stream);
  if (e != hipSuccess) fprintf(stderr, "cooperative launch failed: %s (grid %d)\n", hipGetErrorString(e), grid_blocks);
}
```
